# Optimizing an MI355X kernel written in HIP

```python
import math
import jax, jax.numpy as jnp
from jax import lax
import numpy as np

D_MODEL = 1024
BATCH = 16
SEQ = 2048
DEPTH = 1
DEC_BATCH = 8
DEC_SEQ = 8192
PAST_LEN = 128

N_META = 16
ATTN_WIDTH = D_MODEL // 2
POOL_WIDTH = D_MODEL // 2
MIX_WIDTH = ATTN_WIDTH + POOL_WIDTH
N_ATTN_HEADS = 4
ATTN_DV = ATTN_WIDTH // N_ATTN_HEADS
ATTN_DQK = ATTN_DV // 2
QK_COLS = N_ATTN_HEADS * 2 * ATTN_DQK
POOL_WINDOWS = (2, 4, 8, 16)
N_POOL_GROUPS = len(POOL_WINDOWS)
POOL_GROUP = POOL_WIDTH // N_POOL_GROUPS
IN_COLS = 2 * QK_COLS + ATTN_WIDTH + POOL_WIDTH
D_FF = 2816
N_BUCKETS = 32
MAX_DISTANCE = 128
Q_BLOCK = 128
EPS = 1e-6

kernel_name = "hymba_diffattn_pool_macaron_encoder"


def _rmsnorm(x, g):
    xf = x.astype(jnp.float32)
    y = xf * lax.rsqrt(jnp.mean(xf * xf, axis=-1, keepdims=True) + EPS)
    return (y * g.astype(jnp.float32)).astype(x.dtype)


def _swiglu(x, w_gate, w_up, w_down):
    return (jax.nn.silu(x @ w_gate) * (x @ w_up)) @ w_down


def _rel_bucket(rel):
    half = N_BUCKETS // 2
    max_exact = half // 2
    ret = jnp.where(rel > 0, half, 0)
    n = jnp.abs(rel)
    nf = jnp.maximum(n, 1).astype(jnp.float32)
    large = max_exact + (jnp.log(nf / max_exact) / math.log(MAX_DISTANCE / max_exact)
                         * (half - max_exact)).astype(jnp.int32)
    large = jnp.minimum(large, half - 1)
    return ret + jnp.where(n < max_exact, n, large)


def _diff_attention(q, k, v, lam, bias_table):
    B, L = q.shape[0], q.shape[1]
    nb = -(-L // Q_BLOCK)
    Lp = nb * Q_BLOCK
    qp = jnp.pad(q, ((0, 0), (0, Lp - L), (0, 0), (0, 0), (0, 0)))
    qb = qp.reshape(B, nb, Q_BLOCK, N_ATTN_HEADS, 2, ATTN_DQK).transpose(1, 0, 2, 3, 4, 5)
    qpos = jnp.arange(Lp, dtype=jnp.int32).reshape(nb, Q_BLOCK)
    kpos = jnp.arange(L, dtype=jnp.int32)
    scale = ATTN_DQK ** -0.5

    def block(args):
        q_blk, pos = args
        bucket = _rel_bucket(kpos[None, :] - pos[:, None])
        bias = jnp.take(bias_table, bucket, axis=0).astype(jnp.float32)
        bias = bias.transpose(2, 0, 1)
        logits = jnp.einsum('bqhcd,bkhcd->bhcqk', q_blk, k).astype(jnp.float32) * scale
        logits = logits + bias[None, :, None]
        p = jax.nn.softmax(logits, axis=-1)
        a = p[:, :, 0] - lam * p[:, :, 1]
        return jnp.einsum('bhqk,bkhd->bqhd', a.astype(v.dtype), v)

    o = lax.map(block, (qb, qpos))
    o = o.transpose(1, 0, 2, 3, 4).reshape(B, Lp, N_ATTN_HEADS, ATTN_DV)
    return o[:, :L]


def _pool_mixer(u, pool_w, pool_scale):
    B, L = u.shape[0], u.shape[1]
    ug = u.reshape(B, L, N_POOL_GROUPS, POOL_GROUP)
    pos = jnp.arange(L, dtype=jnp.int32)
    outs = []
    for g, w in enumerate(POOL_WINDOWS):
        xg = ug[:, :, g].astype(jnp.float32)
        cs = jnp.concatenate([jnp.zeros((B, 1, POOL_GROUP), jnp.float32),
                              jnp.cumsum(xg, axis=1)], axis=1)
        lo = jnp.clip(pos - w // 2, 0, L)
        hi = jnp.clip(pos + w // 2, 0, L)
        cnt = (hi - lo).astype(jnp.float32)[None, :, None]
        mean = (jnp.take(cs, hi, axis=1) - jnp.take(cs, lo, axis=1)) / cnt
        outs.append((mean - xg).astype(u.dtype))
    pooled = jnp.stack(outs, axis=2)
    mixed = jnp.einsum('blgc,gcd->blgd', pooled, pool_w)
    return mixed.reshape(B, L, POOL_WIDTH) * pool_scale


def _encode(x, meta_tokens, rel_bias_table,
            norm_ffn1, ffn1_w_gate, ffn1_w_up, ffn1_w_down,
            norm_mix, w_in, lambda_q1, lambda_k1, lambda_q2, lambda_k2, subln_gain,
            pool_w, pool_scale, w_out,
            norm_ffn2, ffn2_w_gate, ffn2_w_up, ffn2_w_down, norm_final):
    B = x.shape[0]
    meta = jnp.broadcast_to(meta_tokens[None].astype(x.dtype), (B, N_META, D_MODEL))
    h = jnp.concatenate([meta, x], axis=1)
    L = h.shape[1]
    for l in range(DEPTH):
        lambda_init = 0.8 - 0.6 * math.exp(-0.3 * l)
        h = h + 0.5 * _swiglu(_rmsnorm(h, norm_ffn1[l]), ffn1_w_gate[l], ffn1_w_up[l], ffn1_w_down[l])
        u = _rmsnorm(h, norm_mix[l]) @ w_in[l]
        q = u[..., :QK_COLS].reshape(B, L, N_ATTN_HEADS, 2, ATTN_DQK)
        k = u[..., QK_COLS:2 * QK_COLS].reshape(B, L, N_ATTN_HEADS, 2, ATTN_DQK)
        v = u[..., 2 * QK_COLS:2 * QK_COLS + ATTN_WIDTH].reshape(B, L, N_ATTN_HEADS, ATTN_DV)
        p_in = u[..., 2 * QK_COLS + ATTN_WIDTH:]
        lam = (jnp.exp(jnp.sum(lambda_q1[l].astype(jnp.float32) * lambda_k1[l].astype(jnp.float32)))
               - jnp.exp(jnp.sum(lambda_q2[l].astype(jnp.float32) * lambda_k2[l].astype(jnp.float32)))
               + lambda_init)
        o = _diff_attention(q, k, v, lam, rel_bias_table)
        o = _rmsnorm(o, subln_gain[l]) * (1.0 - lambda_init)
        attn_out = o.reshape(B, L, ATTN_WIDTH)
        pool_out = _pool_mixer(p_in, pool_w[l], pool_scale[l])
        h = h + jnp.concatenate([attn_out, pool_out], axis=-1) @ w_out[l]
        h = h + 0.5 * _swiglu(_rmsnorm(h, norm_ffn2[l]), ffn2_w_gate[l], ffn2_w_up[l], ffn2_w_down[l])
    h = _rmsnorm(h, norm_final)
    return h[:, N_META:]


def setup_inputs(seed: int = 0) -> dict:
    key = jax.random.key(seed)
    ks = jax.random.split(key, 32)
    f32 = jnp.float32

    def nrm(k, shape, scale):
        return jax.random.normal(k, shape, f32) * scale

    def gain(k, shape):
        return 1.0 + 0.02 * jax.random.normal(k, shape, f32)

    return {
        "x_prompt": nrm(ks[0], (BATCH, SEQ, D_MODEL), 1.0),
        "x_sample": nrm(ks[1], (DEC_BATCH, DEC_SEQ, D_MODEL), 1.0),
        "meta_tokens": nrm(ks[2], (N_META, D_MODEL), 1.0),
        "rel_bias_table": nrm(ks[3], (N_BUCKETS, N_ATTN_HEADS), 0.5),
        "norm_ffn1": gain(ks[4], (DEPTH, D_MODEL)),
        "ffn1_w_gate": nrm(ks[5], (DEPTH, D_MODEL, D_FF), D_MODEL ** -0.5),
        "ffn1_w_up": nrm(ks[6], (DEPTH, D_MODEL, D_FF), D_MODEL ** -0.5),
        "ffn1_w_down": nrm(ks[7], (DEPTH, D_FF, D_MODEL), D_FF ** -0.5),
        "norm_mix": gain(ks[8], (DEPTH, D_MODEL)),
        "w_in": nrm(ks[9], (DEPTH, D_MODEL, IN_COLS), D_MODEL ** -0.5),
        "lambda_q1": nrm(ks[10], (DEPTH, ATTN_DQK), 0.1),
        "lambda_k1": nrm(ks[11], (DEPTH, ATTN_DQK), 0.1),
        "lambda_q2": nrm(ks[12], (DEPTH, ATTN_DQK), 0.1),
        "lambda_k2": nrm(ks[13], (DEPTH, ATTN_DQK), 0.1),
        "subln_gain": gain(ks[14], (DEPTH, ATTN_DV)),
        "pool_w": nrm(ks[15], (DEPTH, N_POOL_GROUPS, POOL_GROUP, POOL_GROUP), POOL_GROUP ** -0.5),
        "pool_scale": 1.0 + 0.1 * jax.random.normal(ks[16], (DEPTH, POOL_WIDTH), f32),
        "w_out": nrm(ks[17], (DEPTH, MIX_WIDTH, D_MODEL), MIX_WIDTH ** -0.5),
        "norm_ffn2": gain(ks[18], (DEPTH, D_MODEL)),
        "ffn2_w_gate": nrm(ks[19], (DEPTH, D_MODEL, D_FF), D_MODEL ** -0.5),
        "ffn2_w_up": nrm(ks[20], (DEPTH, D_MODEL, D_FF), D_MODEL ** -0.5),
        "ffn2_w_down": nrm(ks[21], (DEPTH, D_FF, D_MODEL), D_FF ** -0.5),
        "norm_final": gain(ks[22], (D_MODEL,)),
    }


def reference(x_prompt, x_sample, meta_tokens, rel_bias_table,
              norm_ffn1, ffn1_w_gate, ffn1_w_up, ffn1_w_down,
              norm_mix, w_in, lambda_q1, lambda_k1, lambda_q2, lambda_k2, subln_gain,
              pool_w, pool_scale, w_out,
              norm_ffn2, ffn2_w_gate, ffn2_w_up, ffn2_w_down, norm_final):
    y_prompt = _encode(x_prompt, meta_tokens, rel_bias_table,
                       norm_ffn1, ffn1_w_gate, ffn1_w_up, ffn1_w_down,
                       norm_mix, w_in, lambda_q1, lambda_k1, lambda_q2, lambda_k2, subln_gain,
                       pool_w, pool_scale, w_out,
                       norm_ffn2, ffn2_w_gate, ffn2_w_up, ffn2_w_down, norm_final)
    y_sample = _encode(x_sample, meta_tokens, rel_bias_table,
                       norm_ffn1, ffn1_w_gate, ffn1_w_up, ffn1_w_down,
                       norm_mix, w_in, lambda_q1, lambda_k1, lambda_q2, lambda_k2, subln_gain,
                       pool_w, pool_scale, w_out,
                       norm_ffn2, ffn2_w_gate, ffn2_w_up, ffn2_w_down, norm_final)
    return (y_prompt, y_sample)
```

```cpp
#include <hip/hip_runtime.h>
#include <hip/hip_cooperative_groups.h>
#include <cstdio>
#include <cstdint>
namespace cg = cooperative_groups;

#ifndef MK_MULTI
#define MK_MULTI 0
#endif

#define LAS __attribute__((address_space(3)))
typedef unsigned short bf16_t;
typedef short bf16x8 __attribute__((ext_vector_type(8)));
typedef float f32x4 __attribute__((ext_vector_type(4)));
typedef float f32x16 __attribute__((ext_vector_type(16)));
typedef unsigned u32x4 __attribute__((ext_vector_type(4)));
typedef unsigned u32x2 __attribute__((ext_vector_type(2)));

constexpr int D = 1024, FF = 2816, NMETA = 16;
constexpr int NB1 = 16, S1 = 2048, NB2 = 8, S2 = 8192;
constexpr int L1 = S1 + NMETA, L2 = S2 + NMETA;
constexpr int M1 = NB1 * L1, M2 = NB2 * L2;
constexpr int MTOK = M1 + M2;
constexpr int MPAD = 98816;
constexpr int NOUT_ROWS = NB1 * S1 + NB2 * S2;
constexpr int NREAL = NOUT_ROWS, META0 = NREAL;
constexpr float EPS = 1e-6f;
constexpr float LOG2E = 1.4426950408889634f;
constexpr float C2 = 0.125f * LOG2E;
constexpr float SSQ_SCALE = 1048576.0f;

constexpr size_t MiB = 1u << 20;
constexpr size_t WS_CTL = 0;
constexpr size_t WS_SSQ = 1 * MiB;
constexpr size_t WS_WGU1 = 8 * MiB, WS_WD1 = 20 * MiB, WS_WIN = 26 * MiB, WS_WOUT = 30 * MiB, WS_WGU2 = 32 * MiB, WS_WD2 = 44 * MiB;
constexpr size_t WS_H = 50 * MiB;
constexpr size_t WS_BIG = 243 * MiB;
constexpr size_t WS_U3 = WS_BIG;
constexpr size_t WS_VT = WS_BIG + (size_t)MPAD * 1536 * 2;
constexpr size_t WS_MIX = WS_VT + (size_t)512 * MPAD * 2;
constexpr size_t WS_H8 = WS_MIX + (size_t)MPAD * 1024 * 2;
constexpr size_t WS_WGU1_8 = WS_H8 + (size_t)MPAD * 1024, WS_WGU2_8 = WS_WGU1_8 + (size_t)2 * FF * D;
constexpr size_t WS_WD1_8 = WS_WGU2_8 + (size_t)2 * FF * D, WS_WD2_8 = WS_WD1_8 + (size_t)D * FF;
constexpr size_t WS_END = WS_WD2_8 + (size_t)D * FF;
constexpr size_t WS_HFFM = 128 * 1024;
constexpr float W8_SCALE = 64.0f, HFF8_SCALE = 8.0f, WD8_SCALE = 128.0f;
static_assert(WS_H + (size_t)MPAD * 2048 <= WS_BIG && WS_BIG + (size_t)MPAD * FF * 2 <= WS_H8, "ws map");
static_assert(WS_END <= 1024 * MiB, "ws map exceeds 1 GiB");

__device__ __forceinline__ unsigned cvt_pk_bf16(float lo, float hi) { unsigned r; asm volatile("v_cvt_pk_bf16_f32 %0, %1, %2" : "=v"(r) : "v"(lo), "v"(hi)); return r; }
typedef int i32x4 __attribute__((ext_vector_type(4)));
typedef int i32x8 __attribute__((ext_vector_type(8)));
__device__ __forceinline__ float clamp8(float v) { return __builtin_fminf(__builtin_fmaxf(v, -448.0f), 448.0f); }
__device__ __forceinline__ unsigned pk4_fp8(float a, float b, float c, float d) { int w = 0; w = __builtin_amdgcn_cvt_pk_fp8_f32(clamp8(a), clamp8(b), w, false); w = __builtin_amdgcn_cvt_pk_fp8_f32(clamp8(c), clamp8(d), w, true); return (unsigned)w; }
__device__ __forceinline__ float bf_lo(unsigned u) { return __uint_as_float(u << 16); }
__device__ __forceinline__ float bf_hi(unsigned u) { return __uint_as_float(u & 0xffff0000u); }
__device__ __forceinline__ float rstd_of(const unsigned long long* ssq, int row) { return rsqrtf((float)ssq[row] * (1.0f / (SSQ_SCALE * 1024.0f)) + EPS); }
__device__ __forceinline__ float wave_sum(float v) {
#pragma unroll
    for (int o = 1; o < 64; o <<= 1) v += __shfl_xor(v, o);
    return v;
}

namespace pg8 {
constexpr int BM = 256, BK = 64, HALF = 128, HTB = HALF * BK * 2, STAGE_BYTES = 8 * HTB, NXCD = 8, WGM = 8;
__host__ __device__ __forceinline__ int lds_byte(int r, int c) { const int st = (r >> 4) * 2 + (c >> 5), rr = r & 15, cc = c & 31, ob = rr * 64 + cc * 2; return st * 1024 + (ob ^ (((ob >> 9) & 1) << 5)); }
__host__ __device__ __forceinline__ void stage_rc(int b, int& R, int& C) { const int st = b / 1024, sb = b % 1024, swz = sb ^ (((sb >> 9) & 1) << 5); R = (st >> 1) * 16 + swz / 64; C = (st & 1) * 32 + (swz % 64) / 2; }
__host__ __device__ __forceinline__ int perm32(int rho) { const int n = rho >> 4, i = rho & 15; return 8 * (i >> 2) + 4 * n + (i & 3); }

struct Unit { int pm, pn; };
template <bool F8> struct FragSel { typedef bf16x8 type; };
template <> struct FragSel<true> { typedef i32x8 type; };
struct Gemm { const bf16_t* A; const bf16_t* Bt; int M, N, K; };

struct StaticOrder {
    int nM, nN, nwg, G, c;
    __host__ __device__ void init(int M, int N, int G_, int c_) { nM = M / BM; nN = N / BM; nwg = nM * nN; G = G_; c = c_; }
    __host__ __device__ bool next(int i, Unit& u) const {
        const long L = (long)i * G + c; if (L >= nwg) return false;
        int wgid = (int)L; { const int q = nwg / NXCD, r = nwg % NXCD, xcd = wgid % NXCD, off = wgid / NXCD; wgid = (xcd < r ? xcd * (q + 1) : r * (q + 1) + (xcd - r) * q) + off; }
        const int nig = WGM * nN, gid = wgid / nig, fm = gid * WGM, gsz = (nM - fm) < WGM ? (nM - fm) : WGM;
        u.pm = fm + ((wgid % nig) % gsz); u.pn = (wgid % nig) / gsz; return true;
    }
};

template <class Epi, class Sched, bool F8 = false>
__device__ __forceinline__ void gemm_phase(LAS unsigned char* lds, const Gemm g, const Sched& S, const Epi& E) {
    int tid = threadIdx.x; asm volatile("" : "+v"(tid));
    const int wid = __builtin_amdgcn_readfirstlane(tid >> 6), lane = tid & 63, wr = wid >> 2, wc = wid & 3, fr = lane & 15, fq = lane >> 4;
    using FragT = typename FragSel<F8>::type; constexpr int NKF = F8 ? 1 : 2;
    unsigned sc1 = 0x7F7F7F7Fu; asm volatile("" : "+v"(sc1));
    const int K = g.K, nt = K / BK;
    unsigned voffA[2], voffB[2];
#pragma unroll
    for (int i = 0; i < 2; ++i) { int R, C; stage_rc(tid * 16 + i * 8192, R, C); const int Rb = (R & ~31) + perm32(R & 31);
        voffA[i] = (unsigned)(R * K + C) * 2u; voffB[i] = (unsigned)(Rb * K + C) * 2u; }
    asm volatile("" : "+v"(voffA[0]), "+v"(voffA[1]), "+v"(voffB[0]), "+v"(voffB[1]));
    const size_t kstep = (size_t)(BK * 2);
    const size_t hstep = (size_t)HALF * K * 2;
    const size_t tstep = 2 * hstep;
    const unsigned ldsw = (unsigned)wid * 1024u;
    const int aoff = lds_byte(wr * 64 + fr, fq * 8), boff = lds_byte(wc * 32 + fr, fq * 8);
#define PG8_SA(b, h) (((b) * 2 + (h)) * HTB)
#define PG8_SB(b, h) ((4 + (b) * 2 + (h)) * HTB)
#define PG8_STAGE(bufoff, gbase, voff) do { _Pragma("unroll") for (int _i = 0; _i < 2; ++_i) \
        __builtin_amdgcn_global_load_lds((const unsigned*)((const char*)(gbase) + (voff)[_i]), (LAS unsigned*)(lds + (bufoff) + ldsw + _i * 8192), 16, 0, 0); } while (0)
#define PG8_LD1(dst, addr) do { if constexpr (F8) { dst[0] = __builtin_shufflevector(*(const LAS i32x4*)(addr), *(const LAS i32x4*)((addr) + 1024), 0, 1, 2, 3, 4, 5, 6, 7); } \
        else { _Pragma("unroll") for (int k = 0; k < NKF; ++k) dst[k] = *(const LAS FragT*)((addr) + k * 1024); } } while (0)
#define PG8_LDA(dst, b, h) do { _Pragma("unroll") for (int m = 0; m < 4; ++m) PG8_LD1(dst[m], lds + PG8_SA(b, h) + aoff + m * 2048); } while (0)
#define PG8_LDB(dst, b, h) do { _Pragma("unroll") for (int n = 0; n < 2; ++n) PG8_LD1(dst[n], lds + PG8_SB(b, h) + boff + n * 2048); } while (0)
#define PG8_MMA(ai, bj, At, Bt) do { __builtin_amdgcn_s_setprio(1); _Pragma("unroll") for (int m = 0; m < 4; ++m) _Pragma("unroll") for (int n = 0; n < 2; ++n) { \
        if constexpr (F8) { asm volatile("v_mfma_scale_f32_16x16x128_f8f6f4 %0, %1, %2, %0, %3, %3 op_sel_hi:[0,0,0]" : "+v"(acc[ai][bj][m][n]) : "v"(Bt[n][0]), "v"(At[m][0]), "v"(sc1)); } \
        else { _Pragma("unroll") for (int k = 0; k < 2; ++k) acc[ai][bj][m][n] = __builtin_amdgcn_mfma_f32_16x16x32_bf16(Bt[n][k], At[m][k], acc[ai][bj][m][n], 0, 0, 0); } } \
        __builtin_amdgcn_s_setprio(0); } while (0)
#define PG8_WAIT_V(n) asm volatile("s_waitcnt vmcnt(" #n ")" ::: "memory")
#define PG8_WAIT_L(n) asm volatile("s_waitcnt lgkmcnt(" #n ")" ::: "memory")
#define PG8_BAR __builtin_amdgcn_s_barrier()
#define PG8_SCHED __builtin_amdgcn_sched_barrier(0)
    Unit cur, nxt; int ui = 0;
    if (!S.next(0, cur)) return;
    f32x4 acc[2][2][4][2];
#pragma unroll
    for (int a = 0; a < 2; ++a)
#pragma unroll
        for (int b = 0; b < 2; ++b)
#pragma unroll
            for (int m = 0; m < 4; ++m)
#pragma unroll
                for (int n = 0; n < 2; ++n) acc[a][b][m][n] = (f32x4){0.f, 0.f, 0.f, 0.f};
    FragT At[4][NKF], B0[2][NKF], B1[2][NKF];
    const char* cA = (const char*)g.A + (size_t)cur.pm * tstep; const char* cB = (const char*)g.Bt + (size_t)cur.pn * tstep;
    PG8_STAGE(PG8_SB(0, 0), cB, voffB); PG8_STAGE(PG8_SB(0, 1), cB + hstep, voffB); PG8_STAGE(PG8_SA(0, 0), cA, voffA); PG8_STAGE(PG8_SA(0, 1), cA + hstep, voffA);
    if (wr == 1) PG8_BAR;
    PG8_WAIT_V(2); PG8_BAR;
    PG8_STAGE(PG8_SB(1, 0), cB + kstep, voffB); PG8_STAGE(PG8_SA(1, 0), cA + kstep, voffA); PG8_STAGE(PG8_SB(1, 1), cB + hstep + kstep, voffB);
    PG8_WAIT_V(6); PG8_BAR;
    for (;;) {
        const bool has_next = S.next(ui + 1, nxt);
        const char* nA = has_next ? (const char*)g.A + (size_t)nxt.pm * tstep : cA; const char* nB = has_next ? (const char*)g.Bt + (size_t)nxt.pn * tstep : cB;
#pragma unroll 1
        for (int t = 0; t < nt; t += 2) {
            const bool last = (t == nt - 2);
            const char* a1 = cA + (size_t)(t + 1) * kstep;
            const char* a2 = last ? nA : cA + (size_t)(t + 2) * kstep; const char* b2 = last ? nB : cB + (size_t)(t + 2) * kstep;
            const char* a3 = a2 + kstep; const char* b3 = b2 + kstep;
            PG8_LDB(B0, 0, 0); PG8_LDB(B1, 0, 1); PG8_SCHED; PG8_LDA(At, 0, 0); PG8_STAGE(PG8_SA(1, 1), a1 + hstep, voffA);
            PG8_WAIT_V(8); PG8_WAIT_L(0); PG8_BAR; PG8_MMA(0, 0, At, B0); PG8_MMA(0, 1, At, B1); PG8_BAR; PG8_SCHED;
            PG8_LDA(At, 0, 1); PG8_STAGE(PG8_SB(0, 0), b2, voffB); PG8_STAGE(PG8_SB(0, 1), b2 + hstep, voffB); PG8_STAGE(PG8_SA(0, 0), a2, voffA);
            PG8_WAIT_V(8); PG8_WAIT_L(0); PG8_BAR; PG8_MMA(1, 0, At, B0); PG8_MMA(1, 1, At, B1); PG8_BAR; PG8_SCHED;
            PG8_LDB(B0, 1, 0); PG8_LDB(B1, 1, 1); PG8_SCHED; PG8_LDA(At, 1, 0); PG8_STAGE(PG8_SA(0, 1), a2 + hstep, voffA);
            PG8_WAIT_V(8); PG8_WAIT_L(0); PG8_BAR; PG8_MMA(0, 0, At, B0); PG8_MMA(0, 1, At, B1); PG8_BAR; PG8_SCHED;
            PG8_LDA(At, 1, 1); PG8_STAGE(PG8_SB(1, 0), b3, voffB); PG8_STAGE(PG8_SB(1, 1), b3 + hstep, voffB); PG8_STAGE(PG8_SA(1, 0), a3, voffA);
            PG8_WAIT_V(8); PG8_WAIT_L(0); PG8_BAR; PG8_MMA(1, 0, At, B0); PG8_MMA(1, 1, At, B1); PG8_BAR; PG8_SCHED;
        }
        if (wr == 0) PG8_BAR;
        if constexpr (F8) { asm volatile("s_nop 15\n\ts_nop 7" ::: "memory"); PG8_SCHED; }
        E(acc, cur, wr, wc, fr, fq);
        if (!has_next) break;
#pragma unroll
        for (int a = 0; a < 2; ++a)
#pragma unroll
            for (int b = 0; b < 2; ++b)
#pragma unroll
                for (int m = 0; m < 4; ++m)
#pragma unroll
                    for (int n = 0; n < 2; ++n) acc[a][b][m][n] = (f32x4){0.f, 0.f, 0.f, 0.f};
        cur = nxt; cA = nA; cB = nB; ++ui;
        if (wr == 1) PG8_BAR;
    }
    PG8_WAIT_V(0);
    PG8_BAR;
#undef PG8_SA
#undef PG8_SB
#undef PG8_STAGE
#undef PG8_LDA
#undef PG8_LD1
#undef PG8_LDB
#undef PG8_MMA
#undef PG8_WAIT_V
#undef PG8_WAIT_L
#undef PG8_BAR
#undef PG8_SCHED
}

__device__ __forceinline__ float silu_mul(float g, float u) { return g * __builtin_amdgcn_rcpf(1.0f + __builtin_amdgcn_exp2f(-g * LOG2E)) * u; }
struct EpiGateUp {
    unsigned char* O; const unsigned long long* ssq; float wsc;
    __device__ __forceinline__ void operator()(const f32x4 (&acc)[2][2][4][2], const Unit& u, int wr, int wc, int fr, int fq) const {
        const int row0 = u.pm * BM + wr * 64 + fr, col0 = u.pn * HALF + wc * 32 + 8 * fq;
#pragma unroll
        for (int ai = 0; ai < 2; ++ai)
#pragma unroll
            for (int m = 0; m < 4; ++m) { const int row = row0 + ai * HALF + m * 16; const float rs = rstd_of(ssq, row) * wsc;
                const f32x4 g0 = acc[ai][0][m][0] * rs, g1 = acc[ai][0][m][1] * rs, u0 = acc[ai][1][m][0] * rs, u1 = acc[ai][1][m][1] * rs;
                u32x2 w; w.x = pk4_fp8(silu_mul(g0[0], u0[0]) * HFF8_SCALE, silu_mul(g0[1], u0[1]) * HFF8_SCALE, silu_mul(g0[2], u0[2]) * HFF8_SCALE, silu_mul(g0[3], u0[3]) * HFF8_SCALE);
                w.y = pk4_fp8(silu_mul(g1[0], u1[0]) * HFF8_SCALE, silu_mul(g1[1], u1[1]) * HFF8_SCALE, silu_mul(g1[2], u1[2]) * HFF8_SCALE, silu_mul(g1[3], u1[3]) * HFF8_SCALE);
                *(u32x2*)(O + (size_t)row * FF + col0) = w; }
    }
};
struct EpiResid {
    bf16_t* H; unsigned long long* ssq_out; unsigned char* H8; float asc;
    __device__ __forceinline__ void operator()(const f32x4 (&acc)[2][2][4][2], const Unit& u, int wr, int wc, int fr, int fq) const {
        const int row0 = u.pm * BM + wr * 64 + fr, col0 = u.pn * BM + wc * 32 + 8 * fq;
#pragma unroll
        for (int ai = 0; ai < 2; ++ai)
#pragma unroll
            for (int m = 0; m < 4; ++m) { const int row = row0 + ai * HALF + m * 16; float ss = 0.f;
#pragma unroll
                for (int bj = 0; bj < 2; ++bj) { bf16_t* p = H + (size_t)row * D + col0 + bj * HALF; const u32x4 hv = *(const u32x4*)p;
                    const f32x4 a0 = acc[ai][bj][m][0] * asc, a1 = acc[ai][bj][m][1] * asc;
                    const float v0 = bf_lo(hv.x) + a0[0], v1 = bf_hi(hv.x) + a0[1], v2 = bf_lo(hv.y) + a0[2], v3 = bf_hi(hv.y) + a0[3];
                    const float v4 = bf_lo(hv.z) + a1[0], v5 = bf_hi(hv.z) + a1[1], v6 = bf_lo(hv.w) + a1[2], v7 = bf_hi(hv.w) + a1[3];
                    ss += (v0 * v0 + v1 * v1) + (v2 * v2 + v3 * v3) + (v4 * v4 + v5 * v5) + (v6 * v6 + v7 * v7);
                    u32x4 w; w.x = cvt_pk_bf16(v0, v1); w.y = cvt_pk_bf16(v2, v3); w.z = cvt_pk_bf16(v4, v5); w.w = cvt_pk_bf16(v6, v7);
                    *(u32x4*)p = w;
                    if (H8) { u32x2 w8; w8.x = pk4_fp8(v0, v1, v2, v3); w8.y = pk4_fp8(v4, v5, v6, v7); *(u32x2*)(H8 + (size_t)row * D + col0 + bj * HALF) = w8; } }
                ss += __shfl_xor(ss, 16); ss += __shfl_xor(ss, 32);
                if (fq == 0) atomicAdd(ssq_out + row, (unsigned long long)(ss * SSQ_SCALE + 0.5f)); }
    }
};
struct EpiRowScale {
    bf16_t* O; int ldc; const unsigned long long* ssq;
    __device__ __forceinline__ void operator()(const f32x4 (&acc)[2][2][4][2], const Unit& u, int wr, int wc, int fr, int fq) const {
        const int row0 = u.pm * BM + wr * 64 + fr, col0 = u.pn * BM + wc * 32 + 8 * fq;
#pragma unroll
        for (int ai = 0; ai < 2; ++ai)
#pragma unroll
            for (int m = 0; m < 4; ++m) { const int row = row0 + ai * HALF + m * 16; const float rs = rstd_of(ssq, row);
#pragma unroll
                for (int bj = 0; bj < 2; ++bj) { const f32x4 v0 = acc[ai][bj][m][0] * rs, v1 = acc[ai][bj][m][1] * rs;
                    u32x4 w; w.x = cvt_pk_bf16(v0[0], v0[1]); w.y = cvt_pk_bf16(v0[2], v0[3]); w.z = cvt_pk_bf16(v1[0], v1[1]); w.w = cvt_pk_bf16(v1[2], v1[3]);
                    *(u32x4*)(O + (size_t)row * ldc + col0 + bj * HALF) = w; } }
    }
};
struct EpiColScale {
    bf16_t* O; int ldc; const unsigned long long* ssq;
    __device__ __forceinline__ void operator()(const f32x4 (&acc)[2][2][4][2], const Unit& u, int wr, int wc, int fr, int fq) const {
        const int row0 = u.pm * BM + wr * 64 + fr, col0 = u.pn * BM + wc * 32 + 8 * fq;
#pragma unroll
        for (int bj = 0; bj < 2; ++bj) {
            float rs[8];
#pragma unroll
            for (int j = 0; j < 8; ++j) rs[j] = rstd_of(ssq, col0 + bj * HALF + j);
#pragma unroll
            for (int ai = 0; ai < 2; ++ai)
#pragma unroll
                for (int m = 0; m < 4; ++m) { const int row = row0 + ai * HALF + m * 16; const f32x4 v0 = acc[ai][bj][m][0], v1 = acc[ai][bj][m][1];
                    u32x4 w; w.x = cvt_pk_bf16(v0[0] * rs[0], v0[1] * rs[1]); w.y = cvt_pk_bf16(v0[2] * rs[2], v0[3] * rs[3]);
                    w.z = cvt_pk_bf16(v1[0] * rs[4], v1[1] * rs[5]); w.w = cvt_pk_bf16(v1[2] * rs[6], v1[3] * rs[7]);
                    *(u32x4*)(O + (size_t)row * ldc + col0 + bj * HALF) = w; }
        }
    }
};
}

template <int MODE>
__device__ __forceinline__ void tr2_item(const float* __restrict__ W, int ldw, int k0, int n0, bf16_t* __restrict__ WT, unsigned char* __restrict__ WT8, int ldt, int dst_row0, int dst_k0,
                                         const float* __restrict__ ks, float cs, float cs8, LAS float* scr, int lane) {
    f32x4 v[16];
#pragma unroll
    for (int i = 0; i < 16; ++i) { const int r = 2 * i + (lane >> 5); v[i] = *(const f32x4*)(W + (size_t)(k0 + r) * ldw + n0 + (lane & 31) * 4); }
#pragma unroll
    for (int i = 0; i < 16; ++i) { const int r = 2 * i + (lane >> 5); const float sc = ks ? ks[k0 + r] : 1.0f; LAS float* d = scr + r * 129 + (lane & 31) * 4;
        d[0] = v[i].x * sc; d[1] = v[i].y * sc; d[2] = v[i].z * sc; d[3] = v[i].w * sc; }
    asm volatile("s_waitcnt lgkmcnt(0)" ::: "memory");
    if constexpr (MODE != 0) { const int c = lane & 1;
#pragma unroll
        for (int j = 0; j < 4; ++j) { const int n = (lane >> 1) + 32 * j; const LAS float* s = scr + (16 * c) * 129 + n;
            u32x4 o; o.x = pk4_fp8(s[0 * 129] * cs8, s[1 * 129] * cs8, s[2 * 129] * cs8, s[3 * 129] * cs8); o.y = pk4_fp8(s[4 * 129] * cs8, s[5 * 129] * cs8, s[6 * 129] * cs8, s[7 * 129] * cs8);
            o.z = pk4_fp8(s[8 * 129] * cs8, s[9 * 129] * cs8, s[10 * 129] * cs8, s[11 * 129] * cs8); o.w = pk4_fp8(s[12 * 129] * cs8, s[13 * 129] * cs8, s[14 * 129] * cs8, s[15 * 129] * cs8);
            *(u32x4*)(WT8 + (size_t)(dst_row0 + n) * ldt + dst_k0 + k0 + 16 * c) = o; }
    }
    if constexpr (MODE != 1) { const int c = lane & 3;
#pragma unroll
        for (int j = 0; j < 8; ++j) { const int n = (lane >> 2) + 16 * j; const LAS float* s = scr + (8 * c) * 129 + n;
            u32x4 o; o.x = cvt_pk_bf16(s[0 * 129] * cs, s[1 * 129] * cs); o.y = cvt_pk_bf16(s[2 * 129] * cs, s[3 * 129] * cs); o.z = cvt_pk_bf16(s[4 * 129] * cs, s[5 * 129] * cs); o.w = cvt_pk_bf16(s[6 * 129] * cs, s[7 * 129] * cs);
            *(u32x4*)(WT + (size_t)(dst_row0 + n) * ldt + dst_k0 + k0 + 8 * c) = o; }
    }
    asm volatile("s_waitcnt lgkmcnt(0)" ::: "memory");
}

struct Args { const float* in[23]; float* out; unsigned char* ws; int ph_lo, ph_hi; };

__device__ __forceinline__ void prologue(const Args& a, LAS unsigned char* lds, int gw, int NGW, int lane, int wave) {
    asm volatile("" : "+v"(lane));
    unsigned char* ws = a.ws;
    LAS float* scr = (LAS float*)(lds + wave * 16512);
    bf16_t* WGU1 = (bf16_t*)(ws + WS_WGU1); bf16_t* WD1 = (bf16_t*)(ws + WS_WD1); bf16_t* WIN = (bf16_t*)(ws + WS_WIN); bf16_t* WOUT = (bf16_t*)(ws + WS_WOUT);
    constexpr int I_GU = (D / 32) * (FF / 128), I_DN = (FF / 32) * (D / 128), I_IN = (D / 32) * (2048 / 128), I_OUT = (512 / 32) * (D / 128);
    constexpr int NITEMS = 6 * I_GU + I_IN + I_OUT;
    static_assert(I_GU == I_DN, "item counts");
#ifdef PROBE_DUP_W
    for (int rep_ = 0; rep_ < 2; ++rep_)
#endif
    for (int it = gw; it < NITEMS; it += NGW) {
        int r = it;
        if (r < 6 * I_GU) {
            const int which = r / I_GU; r -= which * I_GU; const int layer = which / 3, kind = which % 3;
            if (kind < 2) { const int nblk = FF / 128, kb = r / nblk, nb = r % nblk, n0 = nb * 128; const int drow = nb * 256 + kind * 128;
                if (layer) tr2_item<1>(a.in[19 + kind], FF, kb * 32, n0, nullptr, ws + WS_WGU2_8, D, drow, 0, a.in[18], 1.0f, W8_SCALE, scr, lane);
                else tr2_item<2>(a.in[5 + kind], FF, kb * 32, n0, WGU1, ws + WS_WGU1_8, D, drow, 0, a.in[4], 1.0f, W8_SCALE, scr, lane);
            } else { const int nblk = D / 128, kb = r / nblk, nb = r % nblk, n0 = nb * 128;
                if (layer) tr2_item<1>(a.in[21], D, kb * 32, n0, nullptr, ws + WS_WD2_8, FF, n0, 0, nullptr, 0.5f, 0.5f * WD8_SCALE, scr, lane);
                else tr2_item<2>(a.in[7], D, kb * 32, n0, WD1, ws + WS_WD1_8, FF, n0, 0, nullptr, 0.5f, 0.5f * WD8_SCALE, scr, lane); }
            continue;
        }
        r -= 6 * I_GU;
        if (r < I_IN) { const int nblk = 2048 / 128, kb = r / nblk, nb = r % nblk, n0 = nb * 128;
            const int drow = n0 < 1024 ? n0 : (n0 < 1536 ? n0 + 512 : n0 - 512);
            tr2_item<0>(a.in[9], 2048, kb * 32, n0, WIN, nullptr, D, drow, 0, a.in[8], n0 < 512 ? C2 : 1.0f, 0.f, scr, lane); continue; }
        r -= I_IN;
        { const int nblk = D / 128, kb = r / nblk, nb = r % nblk, n0 = nb * 128;
          tr2_item<0>(a.in[17], D, kb * 32, n0, WOUT, nullptr, D, n0, 0, nullptr, 1.0f, 0.f, scr, lane); }
    }
    for (int it = gw; it < 2048; it += NGW) {
        const int g = it >> 9, nb = (it >> 5) & 15, cb = it & 31, n = nb * 64 + lane;
        const float* pw = a.in[15] + (size_t)(g * 128 + cb * 4) * 128; const float* ps = a.in[16] + g * 128; const float* wo = a.in[17] + (size_t)(512 + g * 128) * D + n;
        float acc[4] = {0.f, 0.f, 0.f, 0.f};
#pragma unroll 32
        for (int d = 0; d < 128; ++d) { const float w = wo[(size_t)d * D] * ps[d];
#pragma unroll
            for (int c = 0; c < 4; ++c) acc[c] += pw[c * 128 + d] * w; }
        u32x2 o0; o0.x = cvt_pk_bf16(acc[0], acc[1]); o0.y = cvt_pk_bf16(acc[2], acc[3]);
        *(u32x2*)(WOUT + (size_t)n * D + 512 + g * 128 + cb * 4) = o0;
    }
    bf16_t* H = (bf16_t*)(ws + WS_H); unsigned long long* SSQ = (unsigned long long*)(ws + WS_SSQ);
    for (int row0 = gw * 4; row0 < MPAD; row0 += NGW * 4) {
        f32x4 v[4][4];
#pragma unroll
        for (int i = 0; i < 4; ++i) { const int row = row0 + i;
            if (row < NREAL + NMETA) { const float* src = row < NB1 * S1 ? a.in[0] + (size_t)row * D : (row < NREAL ? a.in[1] + (size_t)(row - NB1 * S1) * D : a.in[2] + (size_t)(row - NREAL) * D);
#pragma unroll
                for (int j = 0; j < 4; ++j) v[i][j] = __builtin_nontemporal_load((const f32x4*)src + lane + 64 * j);
            } else {
#pragma unroll
                for (int j = 0; j < 4; ++j) v[i][j] = (f32x4){0.f, 0.f, 0.f, 0.f};
            } }
#pragma unroll
        for (int i = 0; i < 4; ++i) { const int row = row0 + i; float s = 0.f;
#pragma unroll
            for (int j = 0; j < 4; ++j) s += (v[i][j].x * v[i][j].x + v[i][j].y * v[i][j].y) + (v[i][j].z * v[i][j].z + v[i][j].w * v[i][j].w);
            s = wave_sum(s);
            u32x2* o8 = (u32x2*)(H + (size_t)row * D) + lane;
#pragma unroll
            for (int j = 0; j < 4; ++j) { u32x2 w; w.x = cvt_pk_bf16(v[i][j].x, v[i][j].y); w.y = cvt_pk_bf16(v[i][j].z, v[i][j].w); o8[64 * j] = w;
                ((unsigned*)(ws + WS_H8 + (size_t)row * D))[lane + 64 * j] = pk4_fp8(v[i][j].x, v[i][j].y, v[i][j].z, v[i][j].w); }
            if (lane == 0) { SSQ[row] = (unsigned long long)(s * SSQ_SCALE + 0.5f); SSQ[131072 + row] = 0ull; SSQ[2 * 131072 + row] = 0ull; SSQ[3 * 131072 + row] = 0ull; } }
    }
    if (gw == 0 && lane < 16) ((unsigned*)(ws + WS_CTL))[lane * 64] = 0u;
    {
        static_assert((size_t)NREAL * FF <= (size_t)(META0 + NMETA) * 1536 * 2, "hff (fp8, real rows only) must end below the zeroed U3 rows");
        bf16_t* U3z = (bf16_t*)(ws + WS_U3) + (size_t)(META0 + NMETA) * 1536; bf16_t* VTz = (bf16_t*)(ws + WS_VT) + META0 + NMETA;
        const u32x4 z4 = (u32x4){0u, 0u, 0u, 0u};
        for (int i = gw * 64 + lane; i < 48 * 1536 / 8; i += NGW * 64) *(u32x4*)(U3z + (size_t)i * 8) = z4;
        for (int i = gw * 64 + lane; i < 512 * 6; i += NGW * 64) *(u32x4*)(VTz + (size_t)(i / 6) * MPAD + (i % 6) * 8) = z4;
    }
}

__device__ __forceinline__ void pool_acc(float (&sum)[8], const u32x4 x, float sgn) {
    sum[0] += sgn * bf_lo(x.x); sum[1] += sgn * bf_hi(x.x); sum[2] += sgn * bf_lo(x.y); sum[3] += sgn * bf_hi(x.y);
    sum[4] += sgn * bf_lo(x.z); sum[5] += sgn * bf_hi(x.z); sum[6] += sgn * bf_lo(x.w); sum[7] += sgn * bf_hi(x.w); }
__device__ __forceinline__ void pool_phase(const bf16_t* __restrict__ U3, bf16_t* __restrict__ MIX, int gw, int NGW, int lane) {
    asm volatile("" : "+v"(lane));
    constexpr int NTASK = NREAL / 8;
    const int g = lane >> 4, w2 = 1 << g, col = lane * 8;
    const u32x4 z4 = (u32x4){0u, 0u, 0u, 0u};
    const bf16_t* xcol = U3 + 1024 + col;
    for (int task = gw; task < NTASK; task += NGW) {
        const int r0 = task * 8; int seqbase, L;
        if (r0 < NB1 * S1) { seqbase = r0 & ~(S1 - 1); L = L1; } else { seqbase = NB1 * S1 + ((r0 - NB1 * S1) & ~(S2 - 1)); L = L2; }
        const int t0 = r0 - seqbase + NMETA;
#define XROW(tt) (xcol + (size_t)((tt) < NMETA ? META0 + (tt) : seqbase + (tt) - NMETA) * 1536)
        u32x4 wv[16];
#pragma unroll
        for (int j = 0; j < 16; ++j) { const int tt = t0 - 8 + j; wv[j] = (j >= 8 - w2 && j < 8 + w2 && tt >= 0 && tt < L) ? *(const u32x4*)XROW(tt) : z4; }
        float sum[8];
#pragma unroll
        for (int e = 0; e < 8; ++e) sum[e] = 0.f;
#pragma unroll
        for (int j = 0; j < 16; ++j) pool_acc(sum, wv[j], 1.0f);
        u32x4 xc[8], xa[8], xs[8];
#pragma unroll
        for (int i = 0; i < 8; ++i) { const int t = t0 + i; xc[i] = *(const u32x4*)XROW(t);
            xa[i] = (t + w2 < L) ? *(const u32x4*)XROW(t + w2) : z4; xs[i] = (t - w2 >= 0) ? *(const u32x4*)XROW(t - w2) : z4; }
#pragma unroll
        for (int i = 0; i < 8; ++i) { const int t = t0 + i; const int lo = max(t - w2, 0), hi = min(t + w2, L); const float inv = 1.0f / (float)(hi - lo);
            const u32x4 x = xc[i];
            u32x4 o; o.x = cvt_pk_bf16(sum[0] * inv - bf_lo(x.x), sum[1] * inv - bf_hi(x.x)); o.y = cvt_pk_bf16(sum[2] * inv - bf_lo(x.y), sum[3] * inv - bf_hi(x.y));
            o.z = cvt_pk_bf16(sum[4] * inv - bf_lo(x.z), sum[5] * inv - bf_hi(x.z)); o.w = cvt_pk_bf16(sum[6] * inv - bf_lo(x.w), sum[7] * inv - bf_hi(x.w));
            *(u32x4*)(MIX + (size_t)(r0 + i) * D + 512 + col) = o;
            pool_acc(sum, xa[i], 1.0f); pool_acc(sum, xs[i], -1.0f); }
    }
#undef XROW
}

namespace att {
constexpr int STAGE = 32768;
constexpr int LDS_COMB = 0;
constexpr int LDS_LUT = 131072;
constexpr int LDS_MISC = 131072 + 2048;
constexpr float NEG = -1.0e30f;
constexpr int UNITS_PER_Q = 4 * 64 + 8 * 16;

__device__ __forceinline__ unsigned cvtpk(float lo, float hi) { typedef float f2 __attribute__((ext_vector_type(2))); typedef __bf16 b2 __attribute__((ext_vector_type(2)));
    f2 v = {lo, hi}; b2 b = __builtin_convertvector(v, b2); return __builtin_bit_cast(unsigned, b); }

__device__ __forceinline__ void attn_unit(LAS unsigned char* lds, const bf16_t* __restrict__ U3, const bf16_t* __restrict__ VT, bf16_t* __restrict__ MIX,
                                          const float* __restrict__ tbl, const float* __restrict__ gain, float lam, int grp, int b, int h, int qb) {
    int tid = threadIdx.x; asm volatile("" : "+v"(tid));
    const int lane = tid & 63, r32 = lane & 31, hi = lane >> 5;
    const int w = __builtin_amdgcn_readfirstlane(tid >> 6), c = w >> 2;
    const int S = grp ? S2 : S1, rowbase = grp ? NB1 * S1 + b * S2 : b * S1, NT = (S >> 6) + 1;
    const int qw0 = NMETA + qb * 128 + (w & 3) * 32, q = qw0 + r32;
    LAS float* lut = (LAS float*)(lds + LDS_LUT);
    if (tid < 257) { const int rel = tid - 128, n = rel < 0 ? -rel : rel;
        int bk = n < 8 ? n : 8 + (n >= 12) + (n >= 16) + (n >= 23) + (n >= 32) + (n >= 46) + (n >= 64) + (n >= 91);
        if (rel > 0) bk += 16;
        lut[tid] = tbl[bk * 4 + h] * LOG2E; }
    bf16x8 qr[4];
    { const bf16_t* qp = U3 + (size_t)(rowbase + q - NMETA) * 1536 + h * 128 + c * 64 + hi * 8;
#pragma unroll
      for (int d0 = 0; d0 < 4; ++d0) qr[d0] = *(const bf16x8*)(qp + d0 * 16); }
    const bf16_t* kg[2]; const bf16_t* vg[2];
#pragma unroll
    for (int i = 0; i < 2; ++i) { const int row = 4 * (i * 8 + w) + (lane >> 4), kch = (lane & 15) ^ (row & 15);
        kg[i] = U3 + (size_t)row * 1536 + 512 + h * 128 + kch * 8;
        const int rp = row, p = (lane & 15) ^ (rp & 15), dv = 2 * rp + (p >> 3), ch = p & 7;
        vg[i] = VT + (size_t)(h * 128 + dv) * MPAD + ch * 8; }
#define ATT_DMA(T, SLOT) do { LAS unsigned char* sb_ = lds + (SLOT) * STAGE + w * 1024; const int tr_ = ((T) < NT - 1) ? rowbase + (T) * 64 : META0; \
        __builtin_amdgcn_global_load_lds((const unsigned*)(kg[0] + (size_t)tr_ * 1536), (LAS unsigned*)(sb_), 16, 0, 0); \
        __builtin_amdgcn_global_load_lds((const unsigned*)(kg[1] + (size_t)tr_ * 1536), (LAS unsigned*)(sb_ + 8192), 16, 0, 0); \
        __builtin_amdgcn_global_load_lds((const unsigned*)(vg[0] + tr_), (LAS unsigned*)(sb_ + 16384), 16, 0, 0); \
        __builtin_amdgcn_global_load_lds((const unsigned*)(vg[1] + tr_), (LAS unsigned*)(sb_ + 24576), 16, 0, 0); } while (0)
    const int pi = (r32 & 0x13) | ((r32 & 4) << 1) | ((r32 & 8) >> 1);
    unsigned koff[4], voff[4];
#pragma unroll
    for (int d0 = 0; d0 < 4; ++d0) koff[d0] = pi * 256 + (((c * 8 + d0 * 2 + hi) ^ (pi & 15)) << 4);
#pragma unroll
    for (int j = 0; j < 4; ++j) voff[j] = 16384 + (r32 >> 1) * 256 + (((((r32 & 1) << 3) + 2 * j + hi) ^ (r32 >> 1)) << 4);

    ATT_DMA(0, 0); ATT_DMA(1, 1);
    asm volatile("s_waitcnt vmcnt(4)" ::: "memory");
    asm volatile("s_waitcnt lgkmcnt(0)" ::: "memory"); __builtin_amdgcn_s_barrier(); asm volatile("" ::: "memory");
    const float bL = lut[0], bR = lut[256];
    f32x16 o[4];
#pragma unroll
    for (int d0 = 0; d0 < 4; ++d0)
#pragma unroll
        for (int r = 0; r < 16; ++r) o[d0][r] = 0.f;
    float mhat = 0.f, l = 0.f;
    bf16x8 pf[4];
#pragma unroll
    for (int j = 0; j < 4; ++j) pf[j] = (bf16x8){0, 0, 0, 0, 0, 0, 0, 0};
    int slot = 0, slotp = 0, slot2 = 2;
#define SBAR() __builtin_amdgcn_sched_barrier(0)
#define EXP2(P, R) do { P[R] = __builtin_amdgcn_exp2f(P[R]); P[(R) + 1] = __builtin_amdgcn_exp2f(P[(R) + 1]); ssum += P[R]; ssum += P[(R) + 1]; asm volatile("" : "+v"(P), "+v"(ssum)); } while (0)
#define CVT8(P, B, J) do { u32x4 x_; x_.x = cvtpk(P[B], P[(B) + 1]); x_.y = cvtpk(P[(B) + 2], P[(B) + 3]); x_.z = cvtpk(P[(B) + 4], P[(B) + 5]); x_.w = cvtpk(P[(B) + 6], P[(B) + 7]); pf[J] = __builtin_bit_cast(bf16x8, x_); asm volatile("" : "+v"(pf[J])); } while (0)
#define VRD(J) do { _Pragma("unroll") for (int d0_ = 0; d0_ < 4; ++d0_) vf[(J) & 1][d0_] = *(const LAS bf16x8*)(pbuf + voff[J] + d0_ * 4096); } while (0)
#define PVM(J, D0) do { o[D0] = __builtin_amdgcn_mfma_f32_32x32x16_bf16(vf[(J) & 1][D0], pf[J], o[D0], 0, 0, 0); } while (0)
#define ATT_SCORES() do { \
        const float ci_ = (slow ? 0.f : (farl ? bL : bR)) - mhat; \
        _Pragma("unroll") for (int r = 0; r < 16; ++r) { p0[r] = ci_; p1[r] = ci_; } \
        { bf16x8 ka[4], kb[4]; \
          _Pragma("unroll") for (int d0 = 0; d0 < 4; ++d0) { ka[d0] = *(const LAS bf16x8*)(buf + koff[d0]); kb[d0] = *(const LAS bf16x8*)(buf + koff[d0] + 8192); } \
          SBAR(); \
          __builtin_amdgcn_s_setprio(1); \
          _Pragma("unroll") for (int d0 = 0; d0 < 4; ++d0) { p0 = __builtin_amdgcn_mfma_f32_32x32x16_bf16(ka[d0], qr[d0], p0, 0, 0, 0); p1 = __builtin_amdgcn_mfma_f32_32x32x16_bf16(kb[d0], qr[d0], p1, 0, 0, 0); } \
          __builtin_amdgcn_s_setprio(0); } \
        if (slow) { \
            _Pragma("unroll") for (int r = 0; r < 16; ++r) { const int kv = k0 + (r & 7) + 8 * hi + 16 * (r >> 3); const int rel = kv - q; \
                p0[r] += lut[min(max(rel, -128), 128) + 128]; p1[r] += lut[min(max(rel + 32, -128), 128) + 128]; \
                if (mt) { if (kv >= NMETA) p0[r] = NEG; p1[r] = NEG; } } \
        } \
    } while (0)
#pragma unroll 1
    for (int t = 0; t < NT; ++t) {
        const bool mt = (t == NT - 1); const int k0 = mt ? 0 : NMETA + t * 64; LAS unsigned char* buf = lds + slot * STAGE; LAS unsigned char* pbuf = lds + slotp * STAGE;
        const bool ahead = t + 2 < NT;
        if (ahead) ATT_DMA(t + 2, slot2);
        const int relmax = k0 + 63 - qw0, relmin = k0 - (qw0 + 31);
        const bool farl = relmax <= -91, farr = relmin >= 91;
        const bool slow = !(farl || farr) || mt;
        f32x16 p0, p1;
        ATT_SCORES();
        bf16x8 vf[2][4];
        VRD(0);
        float ssum = 0.f;
        if (t != 0) {
        SBAR();
        VRD(1); SBAR(); PVM(0, 0); EXP2(p0, 0); SBAR(); PVM(0, 1); EXP2(p0, 2); SBAR(); PVM(0, 2); EXP2(p0, 4); SBAR(); PVM(0, 3); EXP2(p0, 6); SBAR();
        VRD(2); SBAR(); PVM(1, 0); EXP2(p0, 8); CVT8(p0, 0, 0); SBAR(); PVM(1, 1); EXP2(p0, 10); SBAR(); PVM(1, 2); EXP2(p0, 12); SBAR(); PVM(1, 3); EXP2(p0, 14); SBAR();
        VRD(3); SBAR(); PVM(2, 0); EXP2(p1, 0); CVT8(p0, 8, 1); SBAR(); PVM(2, 1); EXP2(p1, 2); SBAR(); PVM(2, 2); EXP2(p1, 4); SBAR(); PVM(2, 3); EXP2(p1, 6); SBAR();
        PVM(3, 0); EXP2(p1, 8); CVT8(p1, 0, 2); SBAR(); PVM(3, 1); EXP2(p1, 10); SBAR(); PVM(3, 2); EXP2(p1, 12); SBAR(); PVM(3, 3); EXP2(p1, 14); SBAR();
        CVT8(p1, 8, 3);
        }
        if (t == 0 || __any(!(ssum <= 8192.0f))) {
            if (t != 0) ATT_SCORES();
            float rma = __builtin_fmaxf(__builtin_fmaxf(p0[0], p0[1]), p1[0]), rmb = __builtin_fmaxf(__builtin_fmaxf(p0[2], p0[3]), p1[1]);
            rma = __builtin_fmaxf(__builtin_fmaxf(rma, p1[2]), p1[3]);
#pragma unroll
            for (int r = 4; r < 16; r += 4) { rma = __builtin_fmaxf(__builtin_fmaxf(rma, p0[r]), p0[r + 1]); rmb = __builtin_fmaxf(__builtin_fmaxf(rmb, p0[r + 2]), p0[r + 3]);
                rma = __builtin_fmaxf(__builtin_fmaxf(rma, p1[r]), p1[r + 1]); rmb = __builtin_fmaxf(__builtin_fmaxf(rmb, p1[r + 2]), p1[r + 3]); }
            float rm = __builtin_fmaxf(rma, rmb);
            { auto rr = __builtin_amdgcn_permlane32_swap(__float_as_uint(rm), __float_as_uint(rm), false, false); rm = __builtin_fmaxf(__uint_as_float(rr[0]), __uint_as_float(rr[1])); }
            const float dl = (t == 0) ? rm : fmaxf(rm, 0.f); mhat += dl;
            if (t != 0) { const float fsc = __builtin_amdgcn_exp2f(-dl); l *= fsc;
#pragma unroll
                for (int d0 = 0; d0 < 4; ++d0)
#pragma unroll
                    for (int r = 0; r < 16; ++r) o[d0][r] *= fsc; }
            ssum = 0.f;
#pragma unroll
            for (int r = 0; r < 16; ++r) { p0[r] = __builtin_amdgcn_exp2f(p0[r] - dl); p1[r] = __builtin_amdgcn_exp2f(p1[r] - dl); ssum += p0[r]; ssum += p1[r]; }
            CVT8(p0, 0, 0); CVT8(p0, 8, 1); CVT8(p1, 0, 2); CVT8(p1, 8, 3);
        }
        l += ssum;
        if (ahead) asm volatile("s_waitcnt vmcnt(4)" ::: "memory"); else asm volatile("s_waitcnt vmcnt(0)" ::: "memory");
        asm volatile("s_waitcnt lgkmcnt(0)" ::: "memory"); __builtin_amdgcn_s_barrier(); asm volatile("" ::: "memory");
        slotp = slot; slot = (slot + 1) & 3; slot2 = (slot2 + 1) & 3;
    }
#undef ATT_SCORES
    {
        LAS unsigned char* pbuf = lds + slotp * STAGE; bf16x8 vf[2][4];
        VRD(0);
#pragma unroll
        for (int j = 0; j < 4; ++j) { if (j < 3) VRD((j + 1) & 3); SBAR();
#pragma unroll
            for (int d0 = 0; d0 < 4; ++d0) PVM(j, d0);
            SBAR(); }
    }
    asm volatile("s_waitcnt lgkmcnt(0)" ::: "memory"); __builtin_amdgcn_s_barrier(); asm volatile("" ::: "memory");
#undef SBAR
#undef EXP2
#undef CVT8
#undef VRD
#undef PVM
#undef ATT_DMA
    l += __shfl_xor(l, 32);
    const float inv = 1.0f / l;
    LAS float* comb = (LAS float*)(lds + LDS_COMB) + (w & 3) * 4096 + r32;
    if (c == 1) { const float sc = lam * inv;
#pragma unroll
        for (int d0 = 0; d0 < 4; ++d0)
#pragma unroll
            for (int r = 0; r < 16; ++r) comb[(32 * d0 + (r & 3) + 8 * (r >> 2) + 4 * hi) * 32] = o[d0][r] * sc; }
    __syncthreads();
    if (c == 0) { float ss = 0.f;
#pragma unroll
        for (int d0 = 0; d0 < 4; ++d0)
#pragma unroll
            for (int r = 0; r < 16; ++r) { const float v = o[d0][r] * inv - comb[(32 * d0 + (r & 3) + 8 * (r >> 2) + 4 * hi) * 32]; o[d0][r] = v; ss += v * v; }
        ss += __shfl_xor(ss, 32);
        const float rs = rsqrtf(ss * (1.0f / 128.0f) + EPS) * 0.8f;
        {
            LAS unsigned char* stg = lds + 65536 + (w & 3) * 8704;
#pragma unroll
            for (int d0 = 0; d0 < 4; ++d0)
#pragma unroll
                for (int rg = 0; rg < 4; ++rg) { const int dv = 32 * d0 + 8 * rg; const f32x4 gn = *(const f32x4*)(gain + dv + 4 * hi);
                    u32x2 wv; wv.x = cvt_pk_bf16(o[d0][4 * rg] * rs * gn.x, o[d0][4 * rg + 1] * rs * gn.y); wv.y = cvt_pk_bf16(o[d0][4 * rg + 2] * rs * gn.z, o[d0][4 * rg + 3] * rs * gn.w);
                    *(LAS u32x2*)(stg + r32 * 272 + (dv + 4 * hi) * 2) = wv; }
            asm volatile("s_waitcnt lgkmcnt(0)" ::: "memory");
            bf16_t* op = MIX + (size_t)(rowbase + qw0 - NMETA + (lane >> 4)) * D + h * 128 + (lane & 15) * 8;
#pragma unroll
            for (int i = 0; i < 8; ++i) { const u32x4 v = *(const LAS u32x4*)(stg + (i * 4 + (lane >> 4)) * 272 + (lane & 15) * 16); *(u32x4*)(op + (size_t)(i * 4) * D) = v; }
        }
    }
}

__device__ __forceinline__ void attn_phase(LAS unsigned char* lds, const bf16_t* U3, const bf16_t* VT, bf16_t* MIX, const float* tbl, const float* gain, float lam, unsigned* ctl) {
    volatile LAS int* misc = (volatile LAS int*)(lds + LDS_MISC);
    const int x0 = blockIdx.x & 7;
    for (int qi = 0; qi < 8; ++qi) {
        const int x = (x0 + qi) & 7;
        for (;;) {
            if (threadIdx.x == 0) misc[0] = (int)atomicAdd(ctl + x * 64, 1u);
            __syncthreads();
            const int idx = misc[0];
            __syncthreads();
            if (idx >= UNITS_PER_Q) break;
            int grp, b, h, qb;
            if (idx < 256) { const int i = idx >> 6; qb = idx & 63; const int p = x + 8 * i; grp = 1; b = p >> 2; h = p & 3; }
            else { const int j = idx - 256, i = j >> 4; qb = j & 15; const int p = x + 8 * i; grp = 0; b = p >> 2; h = p & 3; }
            attn_unit(lds, U3, VT, MIX, tbl, gain, lam, grp, b, h, qb);
        }
    }
}
}

__device__ __forceinline__ f32x4 meta_block(const bf16_t* __restrict__ A, int lda, const bf16_t* __restrict__ Bt, int K, int lane) {
    asm volatile("" : "+v"(lane));
    f32x4 acc = (f32x4){0.f, 0.f, 0.f, 0.f};
    const bf16_t* ap = A + (size_t)(lane & 15) * lda + (lane >> 4) * 8; const bf16_t* bp = Bt + (size_t)(lane & 15) * K + (lane >> 4) * 8;
#pragma unroll 8
    for (int k = 0; k < K; k += 32) acc = __builtin_amdgcn_mfma_f32_16x16x32_bf16(*(const bf16x8*)(ap + k), *(const bf16x8*)(bp + k), acc, 0, 0, 0);
    return acc;
}
__device__ __forceinline__ bf16_t bf16_of(float v) { return (bf16_t)(cvt_pk_bf16(v, 0.f) & 0xffffu); }
__device__ __forceinline__ void meta_gateup(const bf16_t* H, const bf16_t* WGU, bf16_t* HFF, const unsigned long long* ssq, int blk, int G, int lane) {
    asm volatile("" : "+v"(lane));
    for (int cb = blk; cb < FF / 16; cb += G) { const int grow = (cb >> 3) * 256 + (cb & 7) * 16;
        const f32x4 g = meta_block(H + (size_t)META0 * D, D, WGU + (size_t)grow * D, D, lane), u = meta_block(H + (size_t)META0 * D, D, WGU + (size_t)(grow + 128) * D, D, lane);
#pragma unroll
        for (int r = 0; r < 4; ++r) { const int row = META0 + 4 * (lane >> 4) + r; const float rs = rstd_of(ssq, row);
            HFF[(size_t)(row - META0) * FF + cb * 16 + (lane & 15)] = bf16_of(pg8::silu_mul(g[r] * rs, u[r] * rs)); } }
}
__device__ __forceinline__ void meta_down(const bf16_t* HFF, const bf16_t* WD, bf16_t* H, unsigned long long* ssq_out, int blk, int G, int lane) {
    asm volatile("" : "+v"(lane));
    for (int cb = blk; cb < D / 16; cb += G) {
        const f32x4 acc = meta_block(HFF, FF, WD + (size_t)cb * 16 * FF, FF, lane);
#pragma unroll
        for (int r = 0; r < 4; ++r) { const int row = META0 + 4 * (lane >> 4) + r; bf16_t* hp = H + (size_t)row * D + cb * 16 + (lane & 15);
            const float v = __uint_as_float((unsigned)*hp << 16) + acc[r]; *hp = bf16_of(v);
            float ss = v * v; ss += __shfl_xor(ss, 1); ss += __shfl_xor(ss, 2); ss += __shfl_xor(ss, 4); ss += __shfl_xor(ss, 8);
            if ((lane & 15) == 0) atomicAdd(ssq_out + row, (unsigned long long)(ss * SSQ_SCALE + 0.5f)); } }
}
__device__ __forceinline__ void meta_win(const bf16_t* H, const bf16_t* WIN, bf16_t* U3, bf16_t* VT, const unsigned long long* ssq, int blk, int G, int lane) {
    asm volatile("" : "+v"(lane));
    for (int cb = blk; cb < 2048 / 16; cb += G) {
        const f32x4 acc = meta_block(H + (size_t)META0 * D, D, WIN + (size_t)cb * 16 * D, D, lane);
#pragma unroll
        for (int r = 0; r < 4; ++r) { const int row = META0 + 4 * (lane >> 4) + r, col = cb * 16 + (lane & 15); const bf16_t v = bf16_of(acc[r] * rstd_of(ssq, row));
            if (col < 1536) U3[(size_t)row * 1536 + col] = v; else VT[(size_t)(col - 1536) * MPAD + row] = v; } }
}

__global__ void __launch_bounds__(512, 2) mk_fwd(Args a) {
    extern __shared__ __attribute__((aligned(16))) unsigned char lds_raw[];
    LAS unsigned char* lds = (LAS unsigned char*)lds_raw;
    cg::grid_group grid = cg::this_grid();
    const int tid = threadIdx.x, lane = tid & 63, wave = __builtin_amdgcn_readfirstlane(tid >> 6);
    const int G = gridDim.x, gw = blockIdx.x * 8 + wave, NGW = G * 8;
    unsigned char* ws = a.ws;
    bf16_t* H = (bf16_t*)(ws + WS_H); unsigned char* HFF = ws + WS_BIG; bf16_t* HFFM = (bf16_t*)(ws + WS_HFFM); bf16_t* U3 = (bf16_t*)(ws + WS_U3); bf16_t* VT = (bf16_t*)(ws + WS_VT); bf16_t* MIX = (bf16_t*)(ws + WS_MIX);
    unsigned long long* SSQ0 = (unsigned long long*)(ws + WS_SSQ); unsigned long long* SSQ1 = SSQ0 + 131072; unsigned long long* SSQ2 = SSQ0 + 2 * 131072; unsigned long long* SSQ3 = SSQ0 + 3 * 131072;
    const int lo = a.ph_lo, hi = a.ph_hi;
#define IN(k) (lo <= (k) && (k) < hi)
#define SEAM(k) do { if (IN(k) && IN((k) + 1)) grid.sync(); } while (0)

    if (IN(0)) prologue(a, lds, gw, NGW, lane, wave);
#ifdef PROBE_DUP_MISC
    if (IN(0)) { __syncthreads(); prologue(a, lds, gw, NGW, lane, wave); }
#endif
    SEAM(0);
#pragma unroll 1
    for (int pass = 0; pass < 2; ++pass) {
        const int pu = pass ? 6 : 1, pd = pass ? 7 : 2;
        if (IN(pu)) {
            if (pass == 0 && wave == 0) meta_gateup(H, (const bf16_t*)(ws + WS_WGU1), HFFM, SSQ0, (int)blockIdx.x, G, lane);
            pg8::Gemm g{(const bf16_t*)(ws + WS_H8), (const bf16_t*)(ws + (pass ? WS_WGU2_8 : WS_WGU1_8)), NREAL, 2 * FF, D / 2}; pg8::StaticOrder S; S.init(NREAL, 2 * FF, G, (int)blockIdx.x);
            pg8::EpiGateUp E{HFF, pass ? SSQ2 : SSQ0, 1.0f / W8_SCALE};
            pg8::gemm_phase<pg8::EpiGateUp, pg8::StaticOrder, true>(lds, g, S, E);
#ifdef PROBE_DUP_GU
            if (pass == 0) pg8::gemm_phase<pg8::EpiGateUp, pg8::StaticOrder>(lds, g, S, E);
#endif
        }
        SEAM(pu);
        if (IN(pd)) {
            if (pass == 0 && wave == 0) meta_down(HFFM, (const bf16_t*)(ws + WS_WD1), H, SSQ1, (int)blockIdx.x, G, lane);
            pg8::Gemm g{(const bf16_t*)HFF, (const bf16_t*)(ws + (pass ? WS_WD2_8 : WS_WD1_8)), NREAL, D, FF / 2}; pg8::StaticOrder S; S.init(NREAL, D, G, (int)blockIdx.x);
            pg8::EpiResid E{H, pass ? SSQ3 : SSQ1, nullptr, 1.0f / (HFF8_SCALE * WD8_SCALE)};
            pg8::gemm_phase<pg8::EpiResid, pg8::StaticOrder, true>(lds, g, S, E);
        }
        SEAM(pd);
        if (pass == 0) {
            if (IN(3)) {
                if (wave == 0) meta_win(H, (const bf16_t*)(ws + WS_WIN), U3, VT, SSQ1, (int)blockIdx.x, G, lane);
                { pg8::Gemm g{H, (const bf16_t*)(ws + WS_WIN), NREAL, 1536, D}; pg8::StaticOrder S; S.init(NREAL, 1536, G, (int)blockIdx.x);
                  pg8::EpiRowScale E{U3, 1536, SSQ1};
                  pg8::gemm_phase<pg8::EpiRowScale, pg8::StaticOrder>(lds, g, S, E); }
                { pg8::Gemm g{(const bf16_t*)(ws + WS_WIN) + (size_t)1536 * D, H, 512, NREAL, D}; pg8::StaticOrder S; S.init(512, NREAL, G, (int)blockIdx.x);
                  pg8::EpiColScale E{VT, MPAD, SSQ1};
                  pg8::gemm_phase<pg8::EpiColScale, pg8::StaticOrder>(lds, g, S, E); }
            }
            SEAM(3);
            if (IN(4)) {
                pool_phase(U3, MIX, gw, NGW, lane);
#ifdef PROBE_DUP_MISC
                pool_phase(U3, MIX, gw, NGW, lane);
#endif
                int ll = lane; asm volatile("" : "+v"(ll));
                const float s1 = wave_sum(a.in[10][ll] * a.in[11][ll]), s2 = wave_sum(a.in[12][ll] * a.in[13][ll]);
                const float lam = __expf(s1) - __expf(s2) + 0.2f;
                att::attn_phase(lds, U3, VT, MIX, a.in[3], a.in[14], lam, (unsigned*)(ws + WS_CTL));
#ifdef PROBE_DUP_ATT
                att::attn_phase(lds, U3, VT, MIX, a.in[3], a.in[14], lam, (unsigned*)(ws + WS_CTL) + 8 * 64);
#endif
            }
            SEAM(4);
            if (IN(5)) {
                pg8::Gemm g{MIX, (const bf16_t*)(ws + WS_WOUT), NREAL, D, D}; pg8::StaticOrder S; S.init(NREAL, D, G, (int)blockIdx.x);
                pg8::EpiResid E{H, SSQ2, ws + WS_H8, 1.0f};
                pg8::gemm_phase<pg8::EpiResid, pg8::StaticOrder>(lds, g, S, E);
            }
            SEAM(5);
        }
    }
    if (IN(8)) {
        const float* gf = a.in[22];
        for (int orow0 = gw * 4; orow0 < NOUT_ROWS; orow0 += NGW * 4) {
            u32x4 hv[4][2]; float rs[4];
#pragma unroll
            for (int i = 0; i < 4; ++i) { const int row = orow0 + i;
                rs[i] = rstd_of(SSQ3, row);
#pragma unroll
                for (int j = 0; j < 2; ++j) hv[i][j] = *(const u32x4*)(H + (size_t)row * D + (j * 64 + lane) * 8); }
#pragma unroll
            for (int j = 0; j < 2; ++j) { const int col = (j * 64 + lane) * 8; const f32x4 g0 = *(const f32x4*)(gf + col), g1 = *(const f32x4*)(gf + col + 4);
#pragma unroll
                for (int i = 0; i < 4; ++i) { const u32x4 h4 = hv[i][j]; const float r = rs[i];
                    f32x4 o0, o1; o0.x = bf_lo(h4.x) * r * g0.x; o0.y = bf_hi(h4.x) * r * g0.y; o0.z = bf_lo(h4.y) * r * g0.z; o0.w = bf_hi(h4.y) * r * g0.w;
                    o1.x = bf_lo(h4.z) * r * g1.x; o1.y = bf_hi(h4.z) * r * g1.y; o1.z = bf_lo(h4.w) * r * g1.z; o1.w = bf_hi(h4.w) * r * g1.w;
                    float* op = a.out + (size_t)(orow0 + i) * D + col; __builtin_nontemporal_store(o0, (f32x4*)op); __builtin_nontemporal_store(o1, (f32x4*)(op + 4)); } }
        }
    }
#undef IN
#undef SEAM
}

constexpr int LDS_BYTES = 147456;
extern "C" void kernel_launch(void* const* d_in, const int* in_sizes, int n_in, void* d_out, int out_size, void* d_ws, size_t ws_size, hipStream_t stream) {
    static int grid = 0;
    if (grid == 0) {
        if (n_in != 23 || out_size != NOUT_ROWS * D || ws_size < WS_END) { fprintf(stderr, "kernel_launch: unexpected shapes (n_in %d, out %d, ws %zu < %zu)\n", n_in, out_size, ws_size, (size_t)WS_END); grid = -1; return; }
        int dev = 0, cus = 0, per_cu = 0;
        (void)hipGetDevice(&dev); (void)hipDeviceGetAttribute(&cus, hipDeviceAttributeMultiprocessorCount, dev);
        (void)hipFuncSetAttribute((const void*)mk_fwd, hipFuncAttributeMaxDynamicSharedMemorySize, LDS_BYTES);
        if (hipOccupancyMaxActiveBlocksPerMultiprocessor(&per_cu, (const void*)mk_fwd, 512, LDS_BYTES) != hipSuccess || per_cu < 1) per_cu = 1;
        (void)hipGetLastError();
        grid = cus * 1;
        if (grid <= 0) grid = 256;
    }
    if (grid < 0) return;
    Args a{};
    for (int i = 0; i < 23; ++i) a.in[i] = (const float*)d_in[i];
    a.out = (float*)d_out; a.ws = (unsigned char*)d_ws;
#if MK_MULTI
    for (int p = 0; p < 9; ++p) { a.ph_lo = p; a.ph_hi = p + 1; hipLaunchKernelGGL(mk_fwd, dim3(grid), dim3(512), LDS_BYTES, stream, a); }
#else
    a.ph_lo = 0; a.ph_hi = 9;
    void* args[] = {&a};
    hipError_t e = hipLaunchCooperativeKernel((const void*)mk_fwd, dim3(grid), dim3(512), args, LDS_BYTES, stream);
    if (e != hipSuccess) fprintf(stderr, "cooperative launch failed: %s (grid %d)\n", hipGetErrorString(e), grid);
#endif
}
```

```cpp
#include <hip/hip_runtime.h>
#include <hip/hip_cooperative_groups.h>
#include <cstdio>
#include <cstdint>
namespace cg = cooperative_groups;

#ifndef MK_MULTI
#define MK_MULTI 0
#endif

#define LAS __attribute__((address_space(3)))
typedef unsigned short bf16_t;
typedef short bf16x8 __attribute__((ext_vector_type(8)));
typedef float f32x4 __attribute__((ext_vector_type(4)));
typedef float f32x16 __attribute__((ext_vector_type(16)));
typedef unsigned u32x4 __attribute__((ext_vector_type(4)));
typedef unsigned u32x2 __attribute__((ext_vector_type(2)));

constexpr int D = 1024, FF = 2816, NMETA = 16;
constexpr int NB1 = 16, S1 = 2048, NB2 = 8, S2 = 8192;
constexpr int L1 = S1 + NMETA, L2 = S2 + NMETA;
constexpr int M1 = NB1 * L1, M2 = NB2 * L2;
constexpr int MTOK = M1 + M2;
constexpr int MPAD = 98816;
constexpr int NOUT_ROWS = NB1 * S1 + NB2 * S2;
constexpr int NREAL = NOUT_ROWS, META0 = NREAL;
constexpr float EPS = 1e-6f;
constexpr float LOG2E = 1.4426950408889634f;
constexpr float C2 = 0.125f * LOG2E;
constexpr float SSQ_SCALE = 1048576.0f;

constexpr size_t MiB = 1u << 20;
constexpr size_t WS_CTL = 0;
constexpr size_t WS_SSQ = 1 * MiB;
constexpr size_t WS_WGU1 = 8 * MiB, WS_WD1 = 20 * MiB, WS_WIN = 26 * MiB, WS_WOUT = 30 * MiB, WS_WGU2 = 32 * MiB, WS_WD2 = 44 * MiB;
constexpr size_t WS_H = 50 * MiB;
constexpr size_t WS_BIG = 243 * MiB;
constexpr size_t WS_U3 = WS_BIG;
constexpr size_t WS_VT = WS_BIG + (size_t)MPAD * 1536 * 2;
constexpr size_t WS_MIX = WS_VT + (size_t)512 * MPAD * 2;
constexpr size_t WS_H8 = WS_MIX + (size_t)MPAD * 1024 * 2;
constexpr size_t WS_WGU1_8 = WS_H8 + (size_t)MPAD * 1024, WS_WGU2_8 = WS_WGU1_8 + (size_t)2 * FF * D;
constexpr size_t WS_WD1_8 = WS_WGU2_8 + (size_t)2 * FF * D, WS_WD2_8 = WS_WD1_8 + (size_t)D * FF;
constexpr size_t WS_END = WS_WD2_8 + (size_t)D * FF;
constexpr size_t WS_HFFM = 128 * 1024;
constexpr float W8_SCALE = 64.0f, HFF8_SCALE = 8.0f, WD8_SCALE = 128.0f;
static_assert(WS_H + (size_t)MPAD * 2048 <= WS_BIG && WS_BIG + (size_t)MPAD * FF * 2 <= WS_H8, "ws map");
static_assert(WS_END <= 1024 * MiB, "ws map exceeds 1 GiB");

__device__ __forceinline__ unsigned cvt_pk_bf16(float lo, float hi) { unsigned r; asm volatile("v_cvt_pk_bf16_f32 %0, %1, %2" : "=v"(r) : "v"(lo), "v"(hi)); return r; }
typedef int i32x4 __attribute__((ext_vector_type(4)));
typedef int i32x8 __attribute__((ext_vector_type(8)));
__device__ __forceinline__ float clamp8(float v) { return __builtin_fminf(__builtin_fmaxf(v, -448.0f), 448.0f); }
__device__ __forceinline__ unsigned pk4_fp8(float a, float b, float c, float d) { int w = 0; w = __builtin_amdgcn_cvt_pk_fp8_f32(clamp8(a), clamp8(b), w, false); w = __builtin_amdgcn_cvt_pk_fp8_f32(clamp8(c), clamp8(d), w, true); return (unsigned)w; }
__device__ __forceinline__ float bf_lo(unsigned u) { return __uint_as_float(u << 16); }
__device__ __forceinline__ float bf_hi(unsigned u) { return __uint_as_float(u & 0xffff0000u); }
__device__ __forceinline__ float rstd_of(const unsigned long long* ssq, int row) { return rsqrtf((float)ssq[row] * (1.0f / (SSQ_SCALE * 1024.0f)) + EPS); }
__device__ __forceinline__ float wave_sum(float v) {
#pragma unroll
    for (int o = 1; o < 64; o <<= 1) v += __shfl_xor(v, o);
    return v;
}

namespace pg8 {
constexpr int BM = 256, BK = 64, HALF = 128, HTB = HALF * BK * 2, STAGE_BYTES = 8 * HTB, NXCD = 8, WGM = 8;
__host__ __device__ __forceinline__ int lds_byte(int r, int c) { const int st = (r >> 4) * 2 + (c >> 5), rr = r & 15, cc = c & 31, ob = rr * 64 + cc * 2; return st * 1024 + (ob ^ (((ob >> 9) & 1) << 5)); }
__host__ __device__ __forceinline__ void stage_rc(int b, int& R, int& C) { const int st = b / 1024, sb = b % 1024, swz = sb ^ (((sb >> 9) & 1) << 5); R = (st >> 1) * 16 + swz / 64; C = (st & 1) * 32 + (swz % 64) / 2; }
__host__ __device__ __forceinline__ int perm32(int rho) { const int n = rho >> 4, i = rho & 15; return 8 * (i >> 2) + 4 * n + (i & 3); }

struct Unit { int pm, pn; };
template <bool F8> struct FragSel { typedef bf16x8 type; };
template <> struct FragSel<true> { typedef i32x8 type; };
struct Gemm { const bf16_t* A; const bf16_t* Bt; int M, N, K; };

struct StaticOrder {
    int nM, nN, nwg, G, c;
    __host__ __device__ void init(int M, int N, int G_, int c_) { nM = M / BM; nN = N / BM; nwg = nM * nN; G = G_; c = c_; }
    __host__ __device__ bool next(int i, Unit& u) const {
        const long L = (long)i * G + c; if (L >= nwg) return false;
        int wgid = (int)L; { const int q = nwg / NXCD, r = nwg % NXCD, xcd = wgid % NXCD, off = wgid / NXCD; wgid = (xcd < r ? xcd * (q + 1) : r * (q + 1) + (xcd - r) * q) + off; }
        const int nig = WGM * nN, gid = wgid / nig, fm = gid * WGM, gsz = (nM - fm) < WGM ? (nM - fm) : WGM;
        u.pm = fm + ((wgid % nig) % gsz); u.pn = (wgid % nig) / gsz; return true;
    }
};

template <class Epi, class Sched, bool F8 = false>
__device__ __forceinline__ void gemm_phase(LAS unsigned char* lds, const Gemm g, const Sched& S, const Epi& E) {
    int tid = threadIdx.x; asm volatile("" : "+v"(tid));
    const int wid = __builtin_amdgcn_readfirstlane(tid >> 6), lane = tid & 63, wr = wid >> 2, wc = wid & 3, fr = lane & 15, fq = lane >> 4;
    using FragT = typename FragSel<F8>::type; constexpr int NKF = F8 ? 1 : 2;
    unsigned sc1 = 0x7F7F7F7Fu; asm volatile("" : "+v"(sc1));
    const int K = g.K, nt = K / BK;
    unsigned voffA[2], voffB[2];
#pragma unroll
    for (int i = 0; i < 2; ++i) { int R, C; stage_rc(tid * 16 + i * 8192, R, C); const int Rb = (R & ~31) + perm32(R & 31);
        voffA[i] = (unsigned)(R * K + C) * 2u; voffB[i] = (unsigned)(Rb * K + C) * 2u; }
    asm volatile("" : "+v"(voffA[0]), "+v"(voffA[1]), "+v"(voffB[0]), "+v"(voffB[1]));
    const size_t kstep = (size_t)(BK * 2);
    const size_t hstep = (size_t)HALF * K * 2;
    const size_t tstep = 2 * hstep;
    const unsigned ldsw = (unsigned)wid * 1024u;
    const int aoff = lds_byte(wr * 64 + fr, fq * 8), boff = lds_byte(wc * 32 + fr, fq * 8);
#define PG8_SA(b, h) (((b) * 2 + (h)) * HTB)
#define PG8_SB(b, h) ((4 + (b) * 2 + (h)) * HTB)
#define PG8_STAGE(bufoff, gbase, voff) do { _Pragma("unroll") for (int _i = 0; _i < 2; ++_i) \
        __builtin_amdgcn_global_load_lds((const unsigned*)((const char*)(gbase) + (voff)[_i]), (LAS unsigned*)(lds + (bufoff) + ldsw + _i * 8192), 16, 0, 0); } while (0)
#define PG8_LD1(dst, addr) do { if constexpr (F8) { dst[0] = __builtin_shufflevector(*(const LAS i32x4*)(addr), *(const LAS i32x4*)((addr) + 1024), 0, 1, 2, 3, 4, 5, 6, 7); } \
        else { _Pragma("unroll") for (int k = 0; k < NKF; ++k) dst[k] = *(const LAS FragT*)((addr) + k * 1024); } } while (0)
#define PG8_LDA(dst, b, h) do { _Pragma("unroll") for (int m = 0; m < 4; ++m) PG8_LD1(dst[m], lds + PG8_SA(b, h) + aoff + m * 2048); } while (0)
#define PG8_LDB(dst, b, h) do { _Pragma("unroll") for (int n = 0; n < 2; ++n) PG8_LD1(dst[n], lds + PG8_SB(b, h) + boff + n * 2048); } while (0)
#define PG8_MMA(ai, bj, At, Bt) do { __builtin_amdgcn_s_setprio(1); _Pragma("unroll") for (int m = 0; m < 4; ++m) _Pragma("unroll") for (int n = 0; n < 2; ++n) { \
        if constexpr (F8) { asm volatile("v_mfma_scale_f32_16x16x128_f8f6f4 %0, %1, %2, %0, %3, %3 op_sel_hi:[0,0,0]" : "+v"(acc[ai][bj][m][n]) : "v"(Bt[n][0]), "v"(At[m][0]), "v"(sc1)); } \
        else { _Pragma("unroll") for (int k = 0; k < 2; ++k) acc[ai][bj][m][n] = __builtin_amdgcn_mfma_f32_16x16x32_bf16(Bt[n][k], At[m][k], acc[ai][bj][m][n], 0, 0, 0); } } \
        __builtin_amdgcn_s_setprio(0); } while (0)
#define PG8_WAIT_V(n) asm volatile("s_waitcnt vmcnt(" #n ")" ::: "memory")
#define PG8_WAIT_L(n) asm volatile("s_waitcnt lgkmcnt(" #n ")" ::: "memory")
#define PG8_BAR __builtin_amdgcn_s_barrier()
#define PG8_SCHED __builtin_amdgcn_sched_barrier(0)
    Unit cur, nxt; int ui = 0;
    if (!S.next(0, cur)) return;
    f32x4 acc[2][2][4][2];
#pragma unroll
    for (int a = 0; a < 2; ++a)
#pragma unroll
        for (int b = 0; b < 2; ++b)
#pragma unroll
            for (int m = 0; m < 4; ++m)
#pragma unroll
                for (int n = 0; n < 2; ++n) acc[a][b][m][n] = (f32x4){0.f, 0.f, 0.f, 0.f};
    FragT At[4][NKF], B0[2][NKF], B1[2][NKF];
    const char* cA = (const char*)g.A + (size_t)cur.pm * tstep; const char* cB = (const char*)g.Bt + (size_t)cur.pn * tstep;
    PG8_STAGE(PG8_SB(0, 0), cB, voffB); PG8_STAGE(PG8_SB(0, 1), cB + hstep, voffB); PG8_STAGE(PG8_SA(0, 0), cA, voffA); PG8_STAGE(PG8_SA(0, 1), cA + hstep, voffA);
    if (wr == 1) PG8_BAR;
    PG8_WAIT_V(2); PG8_BAR;
    PG8_STAGE(PG8_SB(1, 0), cB + kstep, voffB); PG8_STAGE(PG8_SA(1, 0), cA + kstep, voffA); PG8_STAGE(PG8_SB(1, 1), cB + hstep + kstep, voffB);
    PG8_WAIT_V(6); PG8_BAR;
    for (;;) {
        const bool has_next = S.next(ui + 1, nxt);
        const char* nA = has_next ? (const char*)g.A + (size_t)nxt.pm * tstep : cA; const char* nB = has_next ? (const char*)g.Bt + (size_t)nxt.pn * tstep : cB;
#pragma unroll 1
        for (int t = 0; t < nt; t += 2) {
            const bool last = (t == nt - 2);
            const char* a1 = cA + (size_t)(t + 1) * kstep;
            const char* a2 = last ? nA : cA + (size_t)(t + 2) * kstep; const char* b2 = last ? nB : cB + (size_t)(t + 2) * kstep;
            const char* a3 = a2 + kstep; const char* b3 = b2 + kstep;
            PG8_LDB(B0, 0, 0); PG8_LDB(B1, 0, 1); PG8_SCHED; PG8_LDA(At, 0, 0); PG8_STAGE(PG8_SA(1, 1), a1 + hstep, voffA);
            PG8_WAIT_V(8); PG8_WAIT_L(0); PG8_BAR; PG8_MMA(0, 0, At, B0); PG8_MMA(0, 1, At, B1); PG8_BAR; PG8_SCHED;
            PG8_LDA(At, 0, 1); PG8_STAGE(PG8_SB(0, 0), b2, voffB); PG8_STAGE(PG8_SB(0, 1), b2 + hstep, voffB); PG8_STAGE(PG8_SA(0, 0), a2, voffA);
            PG8_WAIT_V(8); PG8_WAIT_L(0); PG8_BAR; PG8_MMA(1, 0, At, B0); PG8_MMA(1, 1, At, B1); PG8_BAR; PG8_SCHED;
            PG8_LDB(B0, 1, 0); PG8_LDB(B1, 1, 1); PG8_SCHED; PG8_LDA(At, 1, 0); PG8_STAGE(PG8_SA(0, 1), a2 + hstep, voffA);
            PG8_WAIT_V(8); PG8_WAIT_L(0); PG8_BAR; PG8_MMA(0, 0, At, B0); PG8_MMA(0, 1, At, B1); PG8_BAR; PG8_SCHED;
            PG8_LDA(At, 1, 1); PG8_STAGE(PG8_SB(1, 0), b3, voffB); PG8_STAGE(PG8_SB(1, 1), b3 + hstep, voffB); PG8_STAGE(PG8_SA(1, 0), a3, voffA);
            PG8_WAIT_V(8); PG8_WAIT_L(0); PG8_BAR; PG8_MMA(1, 0, At, B0); PG8_MMA(1, 1, At, B1); PG8_BAR; PG8_SCHED;
        }
        if (wr == 0) PG8_BAR;
        if constexpr (F8) { asm volatile("s_nop 15\n\ts_nop 7" ::: "memory"); PG8_SCHED; }
        E(acc, cur, wr, wc, fr, fq);
        if (!has_next) break;
#pragma unroll
        for (int a = 0; a < 2; ++a)
#pragma unroll
            for (int b = 0; b < 2; ++b)
#pragma unroll
                for (int m = 0; m < 4; ++m)
#pragma unroll
                    for (int n = 0; n < 2; ++n) acc[a][b][m][n] = (f32x4){0.f, 0.f, 0.f, 0.f};
        cur = nxt; cA = nA; cB = nB; ++ui;
        if (wr == 1) PG8_BAR;
    }
    PG8_WAIT_V(0);
    PG8_BAR;
#undef PG8_SA
#undef PG8_SB
#undef PG8_STAGE
#undef PG8_LDA
#undef PG8_LD1
#undef PG8_LDB
#undef PG8_MMA
#undef PG8_WAIT_V
#undef PG8_WAIT_L
#undef PG8_BAR
#undef PG8_SCHED
}

__device__ __forceinline__ float silu_mul(float g, float u) { return g * __builtin_amdgcn_rcpf(1.0f + __builtin_amdgcn_exp2f(-g * LOG2E)) * u; }
struct EpiGateUp {
    unsigned char* O; const unsigned long long* ssq; float wsc;
    __device__ __forceinline__ void operator()(const f32x4 (&acc)[2][2][4][2], const Unit& u, int wr, int wc, int fr, int fq) const {
        const int row0 = u.pm * BM + wr * 64 + fr, col0 = u.pn * HALF + wc * 32 + 8 * fq;
#pragma unroll
        for (int ai = 0; ai < 2; ++ai)
#pragma unroll
            for (int m = 0; m < 4; ++m) { const int row = row0 + ai * HALF + m * 16; const float rs = rstd_of(ssq, row) * wsc;
                const f32x4 g0 = acc[ai][0][m][0] * rs, g1 = acc[ai][0][m][1] * rs, u0 = acc[ai][1][m][0] * rs, u1 = acc[ai][1][m][1] * rs;
                u32x2 w; w.x = pk4_fp8(silu_mul(g0[0], u0[0]) * HFF8_SCALE, silu_mul(g0[1], u0[1]) * HFF8_SCALE, silu_mul(g0[2], u0[2]) * HFF8_SCALE, silu_mul(g0[3], u0[3]) * HFF8_SCALE);
                w.y = pk4_fp8(silu_mul(g1[0], u1[0]) * HFF8_SCALE, silu_mul(g1[1], u1[1]) * HFF8_SCALE, silu_mul(g1[2], u1[2]) * HFF8_SCALE, silu_mul(g1[3], u1[3]) * HFF8_SCALE);
                *(u32x2*)(O + (size_t)row * FF + col0) = w; }
    }
};
struct EpiResid {
    bf16_t* H; unsigned long long* ssq_out; unsigned char* H8; float asc;
    __device__ __forceinline__ void operator()(const f32x4 (&acc)[2][2][4][2], const Unit& u, int wr, int wc, int fr, int fq) const {
        const int row0 = u.pm * BM + wr * 64 + fr, col0 = u.pn * BM + wc * 32 + 8 * fq;
#pragma unroll
        for (int ai = 0; ai < 2; ++ai)
#pragma unroll
            for (int m = 0; m < 4; ++m) { const int row = row0 + ai * HALF + m * 16; float ss = 0.f;
#pragma unroll
                for (int bj = 0; bj < 2; ++bj) { bf16_t* p = H + (size_t)row * D + col0 + bj * HALF; const u32x4 hv = *(const u32x4*)p;
                    const f32x4 a0 = acc[ai][bj][m][0] * asc, a1 = acc[ai][bj][m][1] * asc;
                    const float v0 = bf_lo(hv.x) + a0[0], v1 = bf_hi(hv.x) + a0[1], v2 = bf_lo(hv.y) + a0[2], v3 = bf_hi(hv.y) + a0[3];
                    const float v4 = bf_lo(hv.z) + a1[0], v5 = bf_hi(hv.z) + a1[1], v6 = bf_lo(hv.w) + a1[2], v7 = bf_hi(hv.w) + a1[3];
                    ss += (v0 * v0 + v1 * v1) + (v2 * v2 + v3 * v3) + (v4 * v4 + v5 * v5) + (v6 * v6 + v7 * v7);
                    u32x4 w; w.x = cvt_pk_bf16(v0, v1); w.y = cvt_pk_bf16(v2, v3); w.z = cvt_pk_bf16(v4, v5); w.w = cvt_pk_bf16(v6, v7);
                    *(u32x4*)p = w;
                    if (H8) { u32x2 w8; w8.x = pk4_fp8(v0, v1, v2, v3); w8.y = pk4_fp8(v4, v5, v6, v7); *(u32x2*)(H8 + (size_t)row * D + col0 + bj * HALF) = w8; } }
                ss += __shfl_xor(ss, 16); ss += __shfl_xor(ss, 32);
                if (fq == 0) atomicAdd(ssq_out + row, (unsigned long long)(ss * SSQ_SCALE + 0.5f)); }
    }
};
struct EpiRowScale {
    bf16_t* O; int ldc; const unsigned long long* ssq;
    __device__ __forceinline__ void operator()(const f32x4 (&acc)[2][2][4][2], const Unit& u, int wr, int wc, int fr, int fq) const {
        const int row0 = u.pm * BM + wr * 64 + fr, col0 = u.pn * BM + wc * 32 + 8 * fq;
#pragma unroll
        for (int ai = 0; ai < 2; ++ai)
#pragma unroll
            for (int m = 0; m < 4; ++m) { const int row = row0 + ai * HALF + m * 16; const float rs = rstd_of(ssq, row);
#pragma unroll
                for (int bj = 0; bj < 2; ++bj) { const f32x4 v0 = acc[ai][bj][m][0] * rs, v1 = acc[ai][bj][m][1] * rs;
                    u32x4 w; w.x = cvt_pk_bf16(v0[0], v0[1]); w.y = cvt_pk_bf16(v0[2], v0[3]); w.z = cvt_pk_bf16(v1[0], v1[1]); w.w = cvt_pk_bf16(v1[2], v1[3]);
                    *(u32x4*)(O + (size_t)row * ldc + col0 + bj * HALF) = w; } }
    }
};
struct EpiColScale {
    bf16_t* O; int ldc; const unsigned long long* ssq;
    __device__ __forceinline__ void operator()(const f32x4 (&acc)[2][2][4][2], const Unit& u, int wr, int wc, int fr, int fq) const {
        const int row0 = u.pm * BM + wr * 64 + fr, col0 = u.pn * BM + wc * 32 + 8 * fq;
#pragma unroll
        for (int bj = 0; bj < 2; ++bj) {
            float rs[8];
#pragma unroll
            for (int j = 0; j < 8; ++j) rs[j] = rstd_of(ssq, col0 + bj * HALF + j);
#pragma unroll
            for (int ai = 0; ai < 2; ++ai)
#pragma unroll
                for (int m = 0; m < 4; ++m) { const int row = row0 + ai * HALF + m * 16; const f32x4 v0 = acc[ai][bj][m][0], v1 = acc[ai][bj][m][1];
                    u32x4 w; w.x = cvt_pk_bf16(v0[0] * rs[0], v0[1] * rs[1]); w.y = cvt_pk_bf16(v0[2] * rs[2], v0[3] * rs[3]);
                    w.z = cvt_pk_bf16(v1[0] * rs[4], v1[1] * rs[5]); w.w = cvt_pk_bf16(v1[2] * rs[6], v1[3] * rs[7]);
                    *(u32x4*)(O + (size_t)row * ldc + col0 + bj * HALF) = w; }
        }
    }
};
}

template <int MODE>
__device__ __forceinline__ void tr2_item(const float* __restrict__ W, int ldw, int k0, int n0, bf16_t* __restrict__ WT, unsigned char* __restrict__ WT8, int ldt, int dst_row0, int dst_k0,
                                         const float* __restrict__ ks, float cs, float cs8, LAS float* scr, int lane) {
    f32x4 v[16];
#pragma unroll
    for (int i = 0; i < 16; ++i) { const int r = 2 * i + (lane >> 5); v[i] = *(const f32x4*)(W + (size_t)(k0 + r) * ldw + n0 + (lane & 31) * 4); }
#pragma unroll
    for (int i = 0; i < 16; ++i) { const int r = 2 * i + (lane >> 5); const float sc = ks ? ks[k0 + r] : 1.0f; LAS float* d = scr + r * 129 + (lane & 31) * 4;
        d[0] = v[i].x * sc; d[1] = v[i].y * sc; d[2] = v[i].z * sc; d[3] = v[i].w * sc; }
    asm volatile("s_waitcnt lgkmcnt(0)" ::: "memory");
    if constexpr (MODE != 0) { const int c = lane & 1;
#pragma unroll
        for (int j = 0; j < 4; ++j) { const int n = (lane >> 1) + 32 * j; const LAS float* s = scr + (16 * c) * 129 + n;
            u32x4 o; o.x = pk4_fp8(s[0 * 129] * cs8, s[1 * 129] * cs8, s[2 * 129] * cs8, s[3 * 129] * cs8); o.y = pk4_fp8(s[4 * 129] * cs8, s[5 * 129] * cs8, s[6 * 129] * cs8, s[7 * 129] * cs8);
            o.z = pk4_fp8(s[8 * 129] * cs8, s[9 * 129] * cs8, s[10 * 129] * cs8, s[11 * 129] * cs8); o.w = pk4_fp8(s[12 * 129] * cs8, s[13 * 129] * cs8, s[14 * 129] * cs8, s[15 * 129] * cs8);
            *(u32x4*)(WT8 + (size_t)(dst_row0 + n) * ldt + dst_k0 + k0 + 16 * c) = o; }
    }
    if constexpr (MODE != 1) { const int c = lane & 3;
#pragma unroll
        for (int j = 0; j < 8; ++j) { const int n = (lane >> 2) + 16 * j; const LAS float* s = scr + (8 * c) * 129 + n;
            u32x4 o; o.x = cvt_pk_bf16(s[0 * 129] * cs, s[1 * 129] * cs); o.y = cvt_pk_bf16(s[2 * 129] * cs, s[3 * 129] * cs); o.z = cvt_pk_bf16(s[4 * 129] * cs, s[5 * 129] * cs); o.w = cvt_pk_bf16(s[6 * 129] * cs, s[7 * 129] * cs);
            *(u32x4*)(WT + (size_t)(dst_row0 + n) * ldt + dst_k0 + k0 + 8 * c) = o; }
    }
    asm volatile("s_waitcnt lgkmcnt(0)" ::: "memory");
}

struct Args { const float* in[23]; float* out; unsigned char* ws; int ph_lo, ph_hi; };

__device__ __forceinline__ void prologue(const Args& a, LAS unsigned char* lds, int gw, int NGW, int lane, int wave) {
    asm volatile("" : "+v"(lane));
    unsigned char* ws = a.ws;
    LAS float* scr = (LAS float*)(lds + wave * 16512);
    bf16_t* WGU1 = (bf16_t*)(ws + WS_WGU1); bf16_t* WD1 = (bf16_t*)(ws + WS_WD1); bf16_t* WIN = (bf16_t*)(ws + WS_WIN); bf16_t* WOUT = (bf16_t*)(ws + WS_WOUT);
    constexpr int I_GU = (D / 32) * (FF / 128), I_DN = (FF / 32) * (D / 128), I_IN = (D / 32) * (2048 / 128), I_OUT = (512 / 32) * (D / 128);
    constexpr int NITEMS = 6 * I_GU + I_IN + I_OUT;
    static_assert(I_GU == I_DN, "item counts");
#ifdef PROBE_DUP_W
    for (int rep_ = 0; rep_ < 2; ++rep_)
#endif
    for (int it = gw; it < NITEMS; it += NGW) {
        int r = it;
        if (r < 6 * I_GU) {
            const int which = r / I_GU; r -= which * I_GU; const int layer = which / 3, kind = which % 3;
            if (kind < 2) { const int nblk = FF / 128, kb = r / nblk, nb = r % nblk, n0 = nb * 128; const int drow = nb * 256 + kind * 128;
                if (layer) tr2_item<1>(a.in[19 + kind], FF, kb * 32, n0, nullptr, ws + WS_WGU2_8, D, drow, 0, a.in[18], 1.0f, W8_SCALE, scr, lane);
                else tr2_item<2>(a.in[5 + kind], FF, kb * 32, n0, WGU1, ws + WS_WGU1_8, D, drow, 0, a.in[4], 1.0f, W8_SCALE, scr, lane);
            } else { const int nblk = D / 128, kb = r / nblk, nb = r % nblk, n0 = nb * 128;
                if (layer) tr2_item<1>(a.in[21], D, kb * 32, n0, nullptr, ws + WS_WD2_8, FF, n0, 0, nullptr, 0.5f, 0.5f * WD8_SCALE, scr, lane);
                else tr2_item<2>(a.in[7], D, kb * 32, n0, WD1, ws + WS_WD1_8, FF, n0, 0, nullptr, 0.5f, 0.5f * WD8_SCALE, scr, lane); }
            continue;
        }
        r -= 6 * I_GU;
        if (r < I_IN) { const int nblk = 2048 / 128, kb = r / nblk, nb = r % nblk, n0 = nb * 128;
            const int drow = n0 < 1024 ? n0 : (n0 < 1536 ? n0 + 512 : n0 - 512);
            tr2_item<0>(a.in[9], 2048, kb * 32, n0, WIN, nullptr, D, drow, 0, a.in[8], n0 < 512 ? C2 : 1.0f, 0.f, scr, lane); continue; }
        r -= I_IN;
        { const int nblk = D / 128, kb = r / nblk, nb = r % nblk, n0 = nb * 128;
          tr2_item<0>(a.in[17], D, kb * 32, n0, WOUT, nullptr, D, n0, 0, nullptr, 1.0f, 0.f, scr, lane); }
    }
    for (int it = gw; it < 2048; it += NGW) {
        const int g = it >> 9, nb = (it >> 5) & 15, cb = it & 31, n = nb * 64 + lane;
        const float* pw = a.in[15] + (size_t)(g * 128 + cb * 4) * 128; const float* ps = a.in[16] + g * 128; const float* wo = a.in[17] + (size_t)(512 + g * 128) * D + n;
        float acc[4] = {0.f, 0.f, 0.f, 0.f};
#pragma unroll 32
        for (int d = 0; d < 128; ++d) { const float w = wo[(size_t)d * D] * ps[d];
#pragma unroll
            for (int c = 0; c < 4; ++c) acc[c] += pw[c * 128 + d] * w; }
        u32x2 o0; o0.x = cvt_pk_bf16(acc[0], acc[1]); o0.y = cvt_pk_bf16(acc[2], acc[3]);
        *(u32x2*)(WOUT + (size_t)n * D + 512 + g * 128 + cb * 4) = o0;
    }
    bf16_t* H = (bf16_t*)(ws + WS_H); unsigned long long* SSQ = (unsigned long long*)(ws + WS_SSQ);
    for (int row0 = gw * 4; row0 < MPAD; row0 += NGW * 4) {
        f32x4 v[4][4];
#pragma unroll
        for (int i = 0; i < 4; ++i) { const int row = row0 + i;
            if (row < NREAL + NMETA) { const float* src = row < NB1 * S1 ? a.in[0] + (size_t)row * D : (row < NREAL ? a.in[1] + (size_t)(row - NB1 * S1) * D : a.in[2] + (size_t)(row - NREAL) * D);
#pragma unroll
                for (int j = 0; j < 4; ++j) v[i][j] = ((const f32x4*)src)[lane + 64 * j];
            } else {
#pragma unroll
                for (int j = 0; j < 4; ++j) v[i][j] = (f32x4){0.f, 0.f, 0.f, 0.f};
            } }
#pragma unroll
        for (int i = 0; i < 4; ++i) { const int row = row0 + i; float s = 0.f;
#pragma unroll
            for (int j = 0; j < 4; ++j) s += (v[i][j].x * v[i][j].x + v[i][j].y * v[i][j].y) + (v[i][j].z * v[i][j].z + v[i][j].w * v[i][j].w);
            s = wave_sum(s);
            u32x2* o8 = (u32x2*)(H + (size_t)row * D) + lane;
#pragma unroll
            for (int j = 0; j < 4; ++j) { u32x2 w; w.x = cvt_pk_bf16(v[i][j].x, v[i][j].y); w.y = cvt_pk_bf16(v[i][j].z, v[i][j].w); o8[64 * j] = w;
                ((unsigned*)(ws + WS_H8 + (size_t)row * D))[lane + 64 * j] = pk4_fp8(v[i][j].x, v[i][j].y, v[i][j].z, v[i][j].w); }
            if (lane == 0) { SSQ[row] = (unsigned long long)(s * SSQ_SCALE + 0.5f); SSQ[131072 + row] = 0ull; SSQ[2 * 131072 + row] = 0ull; SSQ[3 * 131072 + row] = 0ull; } }
    }
    if (gw == 0 && lane < 16) ((unsigned*)(ws + WS_CTL))[lane * 64] = 0u;
    {
        static_assert((size_t)NREAL * FF <= (size_t)(META0 + NMETA) * 1536 * 2, "hff (fp8, real rows only) must end below the zeroed U3 rows");
        bf16_t* U3z = (bf16_t*)(ws + WS_U3) + (size_t)(META0 + NMETA) * 1536; bf16_t* VTz = (bf16_t*)(ws + WS_VT) + META0 + NMETA;
        const u32x4 z4 = (u32x4){0u, 0u, 0u, 0u};
        for (int i = gw * 64 + lane; i < 48 * 1536 / 8; i += NGW * 64) *(u32x4*)(U3z + (size_t)i * 8) = z4;
        for (int i = gw * 64 + lane; i < 512 * 6; i += NGW * 64) *(u32x4*)(VTz + (size_t)(i / 6) * MPAD + (i % 6) * 8) = z4;
    }
}

__device__ __forceinline__ void pool_acc(float (&sum)[8], const u32x4 x, float sgn) {
    sum[0] += sgn * bf_lo(x.x); sum[1] += sgn * bf_hi(x.x); sum[2] += sgn * bf_lo(x.y); sum[3] += sgn * bf_hi(x.y);
    sum[4] += sgn * bf_lo(x.z); sum[5] += sgn * bf_hi(x.z); sum[6] += sgn * bf_lo(x.w); sum[7] += sgn * bf_hi(x.w); }
__device__ __forceinline__ void pool_phase(const bf16_t* __restrict__ U3, bf16_t* __restrict__ MIX, int gw, int NGW, int lane) {
    asm volatile("" : "+v"(lane));
    constexpr int NTASK = NREAL / 8;
    const int g = lane >> 4, w2 = 1 << g, col = lane * 8;
    const u32x4 z4 = (u32x4){0u, 0u, 0u, 0u};
    const bf16_t* xcol = U3 + 1024 + col;
    for (int task = gw; task < NTASK; task += NGW) {
        const int r0 = task * 8; int seqbase, L;
        if (r0 < NB1 * S1) { seqbase = r0 & ~(S1 - 1); L = L1; } else { seqbase = NB1 * S1 + ((r0 - NB1 * S1) & ~(S2 - 1)); L = L2; }
        const int t0 = r0 - seqbase + NMETA;
#define XROW(tt) (xcol + (size_t)((tt) < NMETA ? META0 + (tt) : seqbase + (tt) - NMETA) * 1536)
        u32x4 wv[16];
#pragma unroll
        for (int j = 0; j < 16; ++j) { const int tt = t0 - 8 + j; wv[j] = (j >= 8 - w2 && j < 8 + w2 && tt >= 0 && tt < L) ? *(const u32x4*)XROW(tt) : z4; }
        float sum[8];
#pragma unroll
        for (int e = 0; e < 8; ++e) sum[e] = 0.f;
#pragma unroll
        for (int j = 0; j < 16; ++j) pool_acc(sum, wv[j], 1.0f);
        u32x4 xc[8], xa[8], xs[8];
#pragma unroll
        for (int i = 0; i < 8; ++i) { const int t = t0 + i; xc[i] = *(const u32x4*)XROW(t);
            xa[i] = (t + w2 < L) ? *(const u32x4*)XROW(t + w2) : z4; xs[i] = (t - w2 >= 0) ? *(const u32x4*)XROW(t - w2) : z4; }
#pragma unroll
        for (int i = 0; i < 8; ++i) { const int t = t0 + i; const int lo = max(t - w2, 0), hi = min(t + w2, L); const float inv = 1.0f / (float)(hi - lo);
            const u32x4 x = xc[i];
            u32x4 o; o.x = cvt_pk_bf16(sum[0] * inv - bf_lo(x.x), sum[1] * inv - bf_hi(x.x)); o.y = cvt_pk_bf16(sum[2] * inv - bf_lo(x.y), sum[3] * inv - bf_hi(x.y));
            o.z = cvt_pk_bf16(sum[4] * inv - bf_lo(x.z), sum[5] * inv - bf_hi(x.z)); o.w = cvt_pk_bf16(sum[6] * inv - bf_lo(x.w), sum[7] * inv - bf_hi(x.w));
            *(u32x4*)(MIX + (size_t)(r0 + i) * D + 512 + col) = o;
            pool_acc(sum, xa[i], 1.0f); pool_acc(sum, xs[i], -1.0f); }
    }
#undef XROW
}

namespace att {
constexpr int STAGE = 32768;
constexpr int LDS_COMB = 0;
constexpr int LDS_LUT = 131072;
constexpr int LDS_MISC = 131072 + 2048;
constexpr float NEG = -1.0e30f;
constexpr int UNITS_PER_Q = 4 * 64 + 8 * 16;

__device__ __forceinline__ unsigned cvtpk(float lo, float hi) { typedef float f2 __attribute__((ext_vector_type(2))); typedef __bf16 b2 __attribute__((ext_vector_type(2)));
    f2 v = {lo, hi}; b2 b = __builtin_convertvector(v, b2); return __builtin_bit_cast(unsigned, b); }

__device__ __forceinline__ void attn_unit(LAS unsigned char* lds, const bf16_t* __restrict__ U3, const bf16_t* __restrict__ VT, bf16_t* __restrict__ MIX,
                                          const float* __restrict__ tbl, const float* __restrict__ gain, float lam, int grp, int b, int h, int qb) {
    int tid = threadIdx.x; asm volatile("" : "+v"(tid));
    const int lane = tid & 63, r32 = lane & 31, hi = lane >> 5;
    const int w = __builtin_amdgcn_readfirstlane(tid >> 6), c = w >> 2;
    const int S = grp ? S2 : S1, rowbase = grp ? NB1 * S1 + b * S2 : b * S1, NT = (S >> 6) + 1;
    const int qw0 = NMETA + qb * 128 + (w & 3) * 32, q = qw0 + r32;
    LAS float* lut = (LAS float*)(lds + LDS_LUT);
    if (tid < 257) { const int rel = tid - 128, n = rel < 0 ? -rel : rel;
        int bk = n < 8 ? n : 8 + (n >= 12) + (n >= 16) + (n >= 23) + (n >= 32) + (n >= 46) + (n >= 64) + (n >= 91);
        if (rel > 0) bk += 16;
        lut[tid] = tbl[bk * 4 + h] * LOG2E; }
    bf16x8 qr[4];
    { const bf16_t* qp = U3 + (size_t)(rowbase + q - NMETA) * 1536 + h * 128 + c * 64 + hi * 8;
#pragma unroll
      for (int d0 = 0; d0 < 4; ++d0) qr[d0] = *(const bf16x8*)(qp + d0 * 16); }
    const bf16_t* kg[2]; const bf16_t* vg[2];
#pragma unroll
    for (int i = 0; i < 2; ++i) { const int row = 4 * (i * 8 + w) + (lane >> 4), kch = (lane & 15) ^ (row & 15);
        kg[i] = U3 + (size_t)row * 1536 + 512 + h * 128 + kch * 8;
        const int rp = row, p = (lane & 15) ^ (rp & 15), dv = 2 * rp + (p >> 3), ch = p & 7;
        vg[i] = VT + (size_t)(h * 128 + dv) * MPAD + ch * 8; }
#define ATT_DMA(T, SLOT) do { LAS unsigned char* sb_ = lds + (SLOT) * STAGE + w * 1024; const int tr_ = ((T) < NT - 1) ? rowbase + (T) * 64 : META0; \
        __builtin_amdgcn_global_load_lds((const unsigned*)(kg[0] + (size_t)tr_ * 1536), (LAS unsigned*)(sb_), 16, 0, 0); \
        __builtin_amdgcn_global_load_lds((const unsigned*)(kg[1] + (size_t)tr_ * 1536), (LAS unsigned*)(sb_ + 8192), 16, 0, 0); \
        __builtin_amdgcn_global_load_lds((const unsigned*)(vg[0] + tr_), (LAS unsigned*)(sb_ + 16384), 16, 0, 0); \
        __builtin_amdgcn_global_load_lds((const unsigned*)(vg[1] + tr_), (LAS unsigned*)(sb_ + 24576), 16, 0, 0); } while (0)
    const int pi = (r32 & 0x13) | ((r32 & 4) << 1) | ((r32 & 8) >> 1);
    unsigned koff[4], voff[4];
#pragma unroll
    for (int d0 = 0; d0 < 4; ++d0) koff[d0] = pi * 256 + (((c * 8 + d0 * 2 + hi) ^ (pi & 15)) << 4);
#pragma unroll
    for (int j = 0; j < 4; ++j) voff[j] = 16384 + (r32 >> 1) * 256 + (((((r32 & 1) << 3) + 2 * j + hi) ^ (r32 >> 1)) << 4);

    ATT_DMA(0, 0); ATT_DMA(1, 1);
    asm volatile("s_waitcnt vmcnt(4)" ::: "memory");
    asm volatile("s_waitcnt lgkmcnt(0)" ::: "memory"); __builtin_amdgcn_s_barrier(); asm volatile("" ::: "memory");
    const float bL = lut[0], bR = lut[256];
    f32x16 o[4];
#pragma unroll
    for (int d0 = 0; d0 < 4; ++d0)
#pragma unroll
        for (int r = 0; r < 16; ++r) o[d0][r] = 0.f;
    float mhat = 0.f, l = 0.f;
    bf16x8 pf[4];
#pragma unroll
    for (int j = 0; j < 4; ++j) pf[j] = (bf16x8){0, 0, 0, 0, 0, 0, 0, 0};
    int slot = 0, slotp = 0, slot2 = 2;
#define SBAR() __builtin_amdgcn_sched_barrier(0)
#define EXP2(P, R) do { P[R] = __builtin_amdgcn_exp2f(P[R]); P[(R) + 1] = __builtin_amdgcn_exp2f(P[(R) + 1]); ssum += P[R]; ssum += P[(R) + 1]; asm volatile("" : "+v"(P), "+v"(ssum)); } while (0)
#define CVT8(P, B, J) do { u32x4 x_; x_.x = cvtpk(P[B], P[(B) + 1]); x_.y = cvtpk(P[(B) + 2], P[(B) + 3]); x_.z = cvtpk(P[(B) + 4], P[(B) + 5]); x_.w = cvtpk(P[(B) + 6], P[(B) + 7]); pf[J] = __builtin_bit_cast(bf16x8, x_); asm volatile("" : "+v"(pf[J])); } while (0)
#define VRD(J) do { _Pragma("unroll") for (int d0_ = 0; d0_ < 4; ++d0_) vf[(J) & 1][d0_] = *(const LAS bf16x8*)(pbuf + voff[J] + d0_ * 4096); } while (0)
#define PVM(J, D0) do { __builtin_amdgcn_s_setprio(1); o[D0] = __builtin_amdgcn_mfma_f32_32x32x16_bf16(vf[(J) & 1][D0], pf[J], o[D0], 0, 0, 0); __builtin_amdgcn_s_setprio(0); } while (0)
#define ATT_SCORES() do { \
        const float ci_ = (slow ? 0.f : (farl ? bL : bR)) - mhat; \
        _Pragma("unroll") for (int r = 0; r < 16; ++r) { p0[r] = ci_; p1[r] = ci_; } \
        { bf16x8 ka[4], kb[4]; \
          _Pragma("unroll") for (int d0 = 0; d0 < 4; ++d0) { ka[d0] = *(const LAS bf16x8*)(buf + koff[d0]); kb[d0] = *(const LAS bf16x8*)(buf + koff[d0] + 8192); } \
          SBAR(); \
          __builtin_amdgcn_s_setprio(1); \
          _Pragma("unroll") for (int d0 = 0; d0 < 4; ++d0) { p0 = __builtin_amdgcn_mfma_f32_32x32x16_bf16(ka[d0], qr[d0], p0, 0, 0, 0); p1 = __builtin_amdgcn_mfma_f32_32x32x16_bf16(kb[d0], qr[d0], p1, 0, 0, 0); } \
          __builtin_amdgcn_s_setprio(0); } \
        if (slow) { \
            _Pragma("unroll") for (int r = 0; r < 16; ++r) { const int kv = k0 + (r & 7) + 8 * hi + 16 * (r >> 3); const int rel = kv - q; \
                p0[r] += lut[min(max(rel, -128), 128) + 128]; p1[r] += lut[min(max(rel + 32, -128), 128) + 128]; \
                if (mt) { if (kv >= NMETA) p0[r] = NEG; p1[r] = NEG; } } \
        } \
    } while (0)
#pragma unroll 1
    for (int t = 0; t < NT; ++t) {
        const bool mt = (t == NT - 1); const int k0 = mt ? 0 : NMETA + t * 64; LAS unsigned char* buf = lds + slot * STAGE; LAS unsigned char* pbuf = lds + slotp * STAGE;
        const bool ahead = t + 2 < NT;
        if (ahead) ATT_DMA(t + 2, slot2);
        const int relmax = k0 + 63 - qw0, relmin = k0 - (qw0 + 31);
        const bool farl = relmax <= -91, farr = relmin >= 91;
        const bool slow = !(farl || farr) || mt;
        f32x16 p0, p1;
        ATT_SCORES();
        bf16x8 vf[2][4];
        VRD(0);
        float ssum = 0.f;
        if (t != 0) {
        SBAR();
        VRD(1); SBAR(); PVM(0, 0); EXP2(p0, 0); SBAR(); PVM(0, 1); EXP2(p0, 2); SBAR(); PVM(0, 2); EXP2(p0, 4); SBAR(); PVM(0, 3); EXP2(p0, 6); SBAR();
        VRD(2); SBAR(); PVM(1, 0); EXP2(p0, 8); CVT8(p0, 0, 0); SBAR(); PVM(1, 1); EXP2(p0, 10); SBAR(); PVM(1, 2); EXP2(p0, 12); SBAR(); PVM(1, 3); EXP2(p0, 14); SBAR();
        VRD(3); SBAR(); PVM(2, 0); EXP2(p1, 0); CVT8(p0, 8, 1); SBAR(); PVM(2, 1); EXP2(p1, 2); SBAR(); PVM(2, 2); EXP2(p1, 4); SBAR(); PVM(2, 3); EXP2(p1, 6); SBAR();
        PVM(3, 0); EXP2(p1, 8); CVT8(p1, 0, 2); SBAR(); PVM(3, 1); EXP2(p1, 10); SBAR(); PVM(3, 2); EXP2(p1, 12); SBAR(); PVM(3, 3); EXP2(p1, 14); SBAR();
        CVT8(p1, 8, 3);
        }
        if (t == 0 || __any(!(ssum <= 8192.0f))) {
            if (t != 0) ATT_SCORES();
            float rma = __builtin_fmaxf(__builtin_fmaxf(p0[0], p0[1]), p1[0]), rmb = __builtin_fmaxf(__builtin_fmaxf(p0[2], p0[3]), p1[1]);
            rma = __builtin_fmaxf(__builtin_fmaxf(rma, p1[2]), p1[3]);
#pragma unroll
            for (int r = 4; r < 16; r += 4) { rma = __builtin_fmaxf(__builtin_fmaxf(rma, p0[r]), p0[r + 1]); rmb = __builtin_fmaxf(__builtin_fmaxf(rmb, p0[r + 2]), p0[r + 3]);
                rma = __builtin_fmaxf(__builtin_fmaxf(rma, p1[r]), p1[r + 1]); rmb = __builtin_fmaxf(__builtin_fmaxf(rmb, p1[r + 2]), p1[r + 3]); }
            float rm = __builtin_fmaxf(rma, rmb);
            { auto rr = __builtin_amdgcn_permlane32_swap(__float_as_uint(rm), __float_as_uint(rm), false, false); rm = __builtin_fmaxf(__uint_as_float(rr[0]), __uint_as_float(rr[1])); }
            const float dl = (t == 0) ? rm : fmaxf(rm, 0.f); mhat += dl;
            if (t != 0) { const float fsc = __builtin_amdgcn_exp2f(-dl); l *= fsc;
#pragma unroll
                for (int d0 = 0; d0 < 4; ++d0)
#pragma unroll
                    for (int r = 0; r < 16; ++r) o[d0][r] *= fsc; }
            ssum = 0.f;
#pragma unroll
            for (int r = 0; r < 16; ++r) { p0[r] = __builtin_amdgcn_exp2f(p0[r] - dl); p1[r] = __builtin_amdgcn_exp2f(p1[r] - dl); ssum += p0[r]; ssum += p1[r]; }
            CVT8(p0, 0, 0); CVT8(p0, 8, 1); CVT8(p1, 0, 2); CVT8(p1, 8, 3);
        }
        l += ssum;
        if (ahead) asm volatile("s_waitcnt vmcnt(4)" ::: "memory"); else asm volatile("s_waitcnt vmcnt(0)" ::: "memory");
        asm volatile("s_waitcnt lgkmcnt(0)" ::: "memory"); __builtin_amdgcn_s_barrier(); asm volatile("" ::: "memory");
        slotp = slot; slot = (slot + 1) & 3; slot2 = (slot2 + 1) & 3;
    }
#undef ATT_SCORES
    {
        LAS unsigned char* pbuf = lds + slotp * STAGE; bf16x8 vf[2][4];
        VRD(0);
#pragma unroll
        for (int j = 0; j < 4; ++j) { if (j < 3) VRD((j + 1) & 3); SBAR();
#pragma unroll
            for (int d0 = 0; d0 < 4; ++d0) PVM(j, d0);
            SBAR(); }
    }
    asm volatile("s_waitcnt lgkmcnt(0)" ::: "memory"); __builtin_amdgcn_s_barrier(); asm volatile("" ::: "memory");
#undef SBAR
#undef EXP2
#undef CVT8
#undef VRD
#undef PVM
#undef ATT_DMA
    l += __shfl_xor(l, 32);
    const float inv = 1.0f / l;
    LAS float* comb = (LAS float*)(lds + LDS_COMB) + (w & 3) * 4096 + r32;
    if (c == 1) { const float sc = lam * inv;
#pragma unroll
        for (int d0 = 0; d0 < 4; ++d0)
#pragma unroll
            for (int r = 0; r < 16; ++r) comb[(32 * d0 + (r & 3) + 8 * (r >> 2) + 4 * hi) * 32] = o[d0][r] * sc; }
    __syncthreads();
    if (c == 0) { float ss = 0.f;
#pragma unroll
        for (int d0 = 0; d0 < 4; ++d0)
#pragma unroll
            for (int r = 0; r < 16; ++r) { const float v = o[d0][r] * inv - comb[(32 * d0 + (r & 3) + 8 * (r >> 2) + 4 * hi) * 32]; o[d0][r] = v; ss += v * v; }
        ss += __shfl_xor(ss, 32);
        const float rs = rsqrtf(ss * (1.0f / 128.0f) + EPS) * 0.8f;
        {
            LAS unsigned char* stg = lds + 65536 + (w & 3) * 8704;
#pragma unroll
            for (int d0 = 0; d0 < 4; ++d0)
#pragma unroll
                for (int rg = 0; rg < 4; ++rg) { const int dv = 32 * d0 + 8 * rg; const f32x4 gn = *(const f32x4*)(gain + dv + 4 * hi);
                    u32x2 wv; wv.x = cvt_pk_bf16(o[d0][4 * rg] * rs * gn.x, o[d0][4 * rg + 1] * rs * gn.y); wv.y = cvt_pk_bf16(o[d0][4 * rg + 2] * rs * gn.z, o[d0][4 * rg + 3] * rs * gn.w);
                    *(LAS u32x2*)(stg + r32 * 272 + (dv + 4 * hi) * 2) = wv; }
            asm volatile("s_waitcnt lgkmcnt(0)" ::: "memory");
            bf16_t* op = MIX + (size_t)(rowbase + qw0 - NMETA + (lane >> 4)) * D + h * 128 + (lane & 15) * 8;
#pragma unroll
            for (int i = 0; i < 8; ++i) { const u32x4 v = *(const LAS u32x4*)(stg + (i * 4 + (lane >> 4)) * 272 + (lane & 15) * 16); *(u32x4*)(op + (size_t)(i * 4) * D) = v; }
        }
    }
}

__device__ __forceinline__ void attn_phase(LAS unsigned char* lds, const bf16_t* U3, const bf16_t* VT, bf16_t* MIX, const float* tbl, const float* gain, float lam, unsigned* ctl) {
    volatile LAS int* misc = (volatile LAS int*)(lds + LDS_MISC);
    const int x0 = blockIdx.x & 7;
    for (int qi = 0; qi < 8; ++qi) {
        const int x = (x0 + qi) & 7;
        for (;;) {
            if (threadIdx.x == 0) misc[0] = (int)atomicAdd(ctl + x * 64, 1u);
            __syncthreads();
            const int idx = misc[0];
            __syncthreads();
            if (idx >= UNITS_PER_Q) break;
            int grp, b, h, qb;
            if (idx < 256) { const int i = idx >> 6; qb = idx & 63; const int p = x + 8 * i; grp = 1; b = p >> 2; h = p & 3; }
            else { const int j = idx - 256, i = j >> 4; qb = j & 15; const int p = x + 8 * i; grp = 0; b = p >> 2; h = p & 3; }
            attn_unit(lds, U3, VT, MIX, tbl, gain, lam, grp, b, h, qb);
        }
    }
}
}

__device__ __forceinline__ f32x4 meta_block(const bf16_t* __restrict__ A, int lda, const bf16_t* __restrict__ Bt, int K, int lane) {
    asm volatile("" : "+v"(lane));
    f32x4 acc = (f32x4){0.f, 0.f, 0.f, 0.f};
    const bf16_t* ap = A + (size_t)(lane & 15) * lda + (lane >> 4) * 8; const bf16_t* bp = Bt + (size_t)(lane & 15) * K + (lane >> 4) * 8;
#pragma unroll 8
    for (int k = 0; k < K; k += 32) acc = __builtin_amdgcn_mfma_f32_16x16x32_bf16(*(const bf16x8*)(ap + k), *(const bf16x8*)(bp + k), acc, 0, 0, 0);
    return acc;
}
__device__ __forceinline__ bf16_t bf16_of(float v) { return (bf16_t)(cvt_pk_bf16(v, 0.f) & 0xffffu); }
__device__ __forceinline__ void meta_gateup(const bf16_t* H, const bf16_t* WGU, bf16_t* HFF, const unsigned long long* ssq, int blk, int G, int lane) {
    asm volatile("" : "+v"(lane));
    for (int cb = blk; cb < FF / 16; cb += G) { const int grow = (cb >> 3) * 256 + (cb & 7) * 16;
        const f32x4 g = meta_block(H + (size_t)META0 * D, D, WGU + (size_t)grow * D, D, lane), u = meta_block(H + (size_t)META0 * D, D, WGU + (size_t)(grow + 128) * D, D, lane);
#pragma unroll
        for (int r = 0; r < 4; ++r) { const int row = META0 + 4 * (lane >> 4) + r; const float rs = rstd_of(ssq, row);
            HFF[(size_t)(row - META0) * FF + cb * 16 + (lane & 15)] = bf16_of(pg8::silu_mul(g[r] * rs, u[r] * rs)); } }
}
__device__ __forceinline__ void meta_down(const bf16_t* HFF, const bf16_t* WD, bf16_t* H, unsigned long long* ssq_out, int blk, int G, int lane) {
    asm volatile("" : "+v"(lane));
    for (int cb = blk; cb < D / 16; cb += G) {
        const f32x4 acc = meta_block(HFF, FF, WD + (size_t)cb * 16 * FF, FF, lane);
#pragma unroll
        for (int r = 0; r < 4; ++r) { const int row = META0 + 4 * (lane >> 4) + r; bf16_t* hp = H + (size_t)row * D + cb * 16 + (lane & 15);
            const float v = __uint_as_float((unsigned)*hp << 16) + acc[r]; *hp = bf16_of(v);
            float ss = v * v; ss += __shfl_xor(ss, 1); ss += __shfl_xor(ss, 2); ss += __shfl_xor(ss, 4); ss += __shfl_xor(ss, 8);
            if ((lane & 15) == 0) atomicAdd(ssq_out + row, (unsigned long long)(ss * SSQ_SCALE + 0.5f)); } }
}
__device__ __forceinline__ void meta_win(const bf16_t* H, const bf16_t* WIN, bf16_t* U3, bf16_t* VT, const unsigned long long* ssq, int blk, int G, int lane) {
    asm volatile("" : "+v"(lane));
    for (int cb = blk; cb < 2048 / 16; cb += G) {
        const f32x4 acc = meta_block(H + (size_t)META0 * D, D, WIN + (size_t)cb * 16 * D, D, lane);
#pragma unroll
        for (int r = 0; r < 4; ++r) { const int row = META0 + 4 * (lane >> 4) + r, col = cb * 16 + (lane & 15); const bf16_t v = bf16_of(acc[r] * rstd_of(ssq, row));
            if (col < 1536) U3[(size_t)row * 1536 + col] = v; else VT[(size_t)(col - 1536) * MPAD + row] = v; } }
}

__global__ void __launch_bounds__(512, 2) mk_fwd(Args a) {
    extern __shared__ __attribute__((aligned(16))) unsigned char lds_raw[];
    LAS unsigned char* lds = (LAS unsigned char*)lds_raw;
    cg::grid_group grid = cg::this_grid();
    const int tid = threadIdx.x, lane = tid & 63, wave = __builtin_amdgcn_readfirstlane(tid >> 6);
    const int G = gridDim.x, gw = blockIdx.x * 8 + wave, NGW = G * 8;
    unsigned char* ws = a.ws;
    bf16_t* H = (bf16_t*)(ws + WS_H); unsigned char* HFF = ws + WS_BIG; bf16_t* HFFM = (bf16_t*)(ws + WS_HFFM); bf16_t* U3 = (bf16_t*)(ws + WS_U3); bf16_t* VT = (bf16_t*)(ws + WS_VT); bf16_t* MIX = (bf16_t*)(ws + WS_MIX);
    unsigned long long* SSQ0 = (unsigned long long*)(ws + WS_SSQ); unsigned long long* SSQ1 = SSQ0 + 131072; unsigned long long* SSQ2 = SSQ0 + 2 * 131072; unsigned long long* SSQ3 = SSQ0 + 3 * 131072;
    const int lo = a.ph_lo, hi = a.ph_hi;
#define IN(k) (lo <= (k) && (k) < hi)
#define SEAM(k) do { if (IN(k) && IN((k) + 1)) grid.sync(); } while (0)

    if (IN(0)) prologue(a, lds, gw, NGW, lane, wave);
#ifdef PROBE_DUP_MISC
    if (IN(0)) { __syncthreads(); prologue(a, lds, gw, NGW, lane, wave); }
#endif
    SEAM(0);
#pragma unroll 1
    for (int pass = 0; pass < 2; ++pass) {
        const int pu = pass ? 6 : 1, pd = pass ? 7 : 2;
        if (IN(pu)) {
            if (pass == 0 && wave == 0) meta_gateup(H, (const bf16_t*)(ws + WS_WGU1), HFFM, SSQ0, (int)blockIdx.x, G, lane);
            pg8::Gemm g{(const bf16_t*)(ws + WS_H8), (const bf16_t*)(ws + (pass ? WS_WGU2_8 : WS_WGU1_8)), NREAL, 2 * FF, D / 2}; pg8::StaticOrder S; S.init(NREAL, 2 * FF, G, (int)blockIdx.x);
            pg8::EpiGateUp E{HFF, pass ? SSQ2 : SSQ0, 1.0f / W8_SCALE};
            pg8::gemm_phase<pg8::EpiGateUp, pg8::StaticOrder, true>(lds, g, S, E);
#ifdef PROBE_DUP_GU
            if (pass == 0) pg8::gemm_phase<pg8::EpiGateUp, pg8::StaticOrder>(lds, g, S, E);
#endif
        }
        SEAM(pu);
        if (IN(pd)) {
            if (pass == 0 && wave == 0) meta_down(HFFM, (const bf16_t*)(ws + WS_WD1), H, SSQ1, (int)blockIdx.x, G, lane);
            pg8::Gemm g{(const bf16_t*)HFF, (const bf16_t*)(ws + (pass ? WS_WD2_8 : WS_WD1_8)), NREAL, D, FF / 2}; pg8::StaticOrder S; S.init(NREAL, D, G, (int)blockIdx.x);
            pg8::EpiResid E{H, pass ? SSQ3 : SSQ1, nullptr, 1.0f / (HFF8_SCALE * WD8_SCALE)};
            pg8::gemm_phase<pg8::EpiResid, pg8::StaticOrder, true>(lds, g, S, E);
        }
        SEAM(pd);
        if (pass == 0) {
            if (IN(3)) {
                if (wave == 0) meta_win(H, (const bf16_t*)(ws + WS_WIN), U3, VT, SSQ1, (int)blockIdx.x, G, lane);
                { pg8::Gemm g{H, (const bf16_t*)(ws + WS_WIN), NREAL, 1536, D}; pg8::StaticOrder S; S.init(NREAL, 1536, G, (int)blockIdx.x);
                  pg8::EpiRowScale E{U3, 1536, SSQ1};
                  pg8::gemm_phase<pg8::EpiRowScale, pg8::StaticOrder>(lds, g, S, E); }
                { pg8::Gemm g{(const bf16_t*)(ws + WS_WIN) + (size_t)1536 * D, H, 512, NREAL, D}; pg8::StaticOrder S; S.init(512, NREAL, G, (int)blockIdx.x);
                  pg8::EpiColScale E{VT, MPAD, SSQ1};
                  pg8::gemm_phase<pg8::EpiColScale, pg8::StaticOrder>(lds, g, S, E); }
            }
            SEAM(3);
            if (IN(4)) {
                pool_phase(U3, MIX, gw, NGW, lane);
#ifdef PROBE_DUP_MISC
                pool_phase(U3, MIX, gw, NGW, lane);
#endif
                int ll = lane; asm volatile("" : "+v"(ll));
                const float s1 = wave_sum(a.in[10][ll] * a.in[11][ll]), s2 = wave_sum(a.in[12][ll] * a.in[13][ll]);
                const float lam = __expf(s1) - __expf(s2) + 0.2f;
                att::attn_phase(lds, U3, VT, MIX, a.in[3], a.in[14], lam, (unsigned*)(ws + WS_CTL));
#ifdef PROBE_DUP_ATT
                att::attn_phase(lds, U3, VT, MIX, a.in[3], a.in[14], lam, (unsigned*)(ws + WS_CTL) + 8 * 64);
#endif
            }
            SEAM(4);
            if (IN(5)) {
                pg8::Gemm g{MIX, (const bf16_t*)(ws + WS_WOUT), NREAL, D, D}; pg8::StaticOrder S; S.init(NREAL, D, G, (int)blockIdx.x);
                pg8::EpiResid E{H, SSQ2, ws + WS_H8, 1.0f};
                pg8::gemm_phase<pg8::EpiResid, pg8::StaticOrder>(lds, g, S, E);
            }
            SEAM(5);
        }
    }
    if (IN(8)) {
        const float* gf = a.in[22];
        for (int orow0 = gw * 4; orow0 < NOUT_ROWS; orow0 += NGW * 4) {
            u32x4 hv[4][2]; float rs[4];
#pragma unroll
            for (int i = 0; i < 4; ++i) { const int row = orow0 + i;
                rs[i] = rstd_of(SSQ3, row);
#pragma unroll
                for (int j = 0; j < 2; ++j) hv[i][j] = *(const u32x4*)(H + (size_t)row * D + (j * 64 + lane) * 8); }
#pragma unroll
            for (int j = 0; j < 2; ++j) { const int col = (j * 64 + lane) * 8; const f32x4 g0 = *(const f32x4*)(gf + col), g1 = *(const f32x4*)(gf + col + 4);
#pragma unroll
                for (int i = 0; i < 4; ++i) { const u32x4 h4 = hv[i][j]; const float r = rs[i];
                    f32x4 o0, o1; o0.x = bf_lo(h4.x) * r * g0.x; o0.y = bf_hi(h4.x) * r * g0.y; o0.z = bf_lo(h4.y) * r * g0.z; o0.w = bf_hi(h4.y) * r * g0.w;
                    o1.x = bf_lo(h4.z) * r * g1.x; o1.y = bf_hi(h4.z) * r * g1.y; o1.z = bf_lo(h4.w) * r * g1.z; o1.w = bf_hi(h4.w) * r * g1.w;
                    float* op = a.out + (size_t)(orow0 + i) * D + col; *(f32x4*)op = o0; *(f32x4*)(op + 4) = o1; } }
        }
    }
#undef IN
#undef SEAM
}

constexpr int LDS_BYTES = 147456;
extern "C" void kernel_launch(void* const* d_in, const int* in_sizes, int n_in, void* d_out, int out_size, void* d_ws, size_t ws_size, hipStream_t stream) {
    static int grid = 0;
    if (grid == 0) {
        if (n_in != 23 || out_size != NOUT_ROWS * D || ws_size < WS_END) { fprintf(stderr, "kernel_launch: unexpected shapes (n_in %d, out %d, ws %zu < %zu)\n", n_in, out_size, ws_size, (size_t)WS_END); grid = -1; return; }
        int dev = 0, cus = 0, per_cu = 0;
        (void)hipGetDevice(&dev); (void)hipDeviceGetAttribute(&cus, hipDeviceAttributeMultiprocessorCount, dev);
        (void)hipFuncSetAttribute((const void*)mk_fwd, hipFuncAttributeMaxDynamicSharedMemorySize, LDS_BYTES);
        if (hipOccupancyMaxActiveBlocksPerMultiprocessor(&per_cu, (const void*)mk_fwd, 512, LDS_BYTES) != hipSuccess || per_cu < 1) per_cu = 1;
        (void)hipGetLastError();
        grid = cus * 1;
        if (grid <= 0) grid = 256;
    }
    if (grid < 0) return;
    Args a{};
    for (int i = 0; i < 23; ++i) a.in[i] = (const float*)d_in[i];
    a.out = (float*)d_out; a.ws = (unsigned char*)d_ws;
#if MK_MULTI
    for (int p = 0; p < 9; ++p) { a.ph_lo = p; a.ph_hi = p + 1; hipLaunchKernelGGL(mk_fwd, dim3(grid), dim3(512), LDS_BYTES, stream, a); }
#else
    a.ph_lo = 0; a.ph_hi = 9;
    void* args[] = {&a};
    hipError_t e = hipLaunchCooperativeKernel((const void*)mk_fwd, dim3(grid), dim3(512), args, LDS_BYTES, stream);
    if (e != hipSuccess) fprintf(stderr, "cooperative launch failed: %s (grid %d)\n", hipGetErrorString(e), grid);
#endif
}
```

```cpp
#include <hip/hip_runtime.h>
#include <hip/hip_cooperative_groups.h>
#include <cstdio>
#include <cstdint>
namespace cg = cooperative_groups;

#ifndef MK_MULTI
#define MK_MULTI 0
#endif

#define LAS __attribute__((address_space(3)))
typedef unsigned short bf16_t;
typedef short bf16x8 __attribute__((ext_vector_type(8)));
typedef float f32x4 __attribute__((ext_vector_type(4)));
typedef float f32x16 __attribute__((ext_vector_type(16)));
typedef unsigned u32x4 __attribute__((ext_vector_type(4)));
typedef unsigned u32x2 __attribute__((ext_vector_type(2)));

constexpr int D = 1024, FF = 2816, NMETA = 16;
constexpr int NB1 = 16, S1 = 2048, NB2 = 8, S2 = 8192;
constexpr int L1 = S1 + NMETA, L2 = S2 + NMETA;
constexpr int M1 = NB1 * L1, M2 = NB2 * L2;
constexpr int MTOK = M1 + M2;
constexpr int MPAD = 98816;
constexpr int NOUT_ROWS = NB1 * S1 + NB2 * S2;
constexpr int NREAL = NOUT_ROWS, META0 = NREAL;
constexpr float EPS = 1e-6f;
constexpr float LOG2E = 1.4426950408889634f;
constexpr float C2 = 0.125f * LOG2E;
constexpr float SSQ_SCALE = 1048576.0f;

constexpr size_t MiB = 1u << 20;
constexpr size_t WS_CTL = 0;
constexpr size_t WS_SSQ = 1 * MiB;
constexpr size_t WS_WGU1 = 8 * MiB, WS_WD1 = 20 * MiB, WS_WIN = 26 * MiB, WS_WOUT = 30 * MiB, WS_WGU2 = 32 * MiB, WS_WD2 = 44 * MiB;
constexpr size_t WS_H = 50 * MiB;
constexpr size_t WS_BIG = 243 * MiB;
constexpr size_t WS_U3 = WS_BIG;
constexpr size_t WS_VT = WS_BIG + (size_t)MPAD * 1536 * 2;
constexpr size_t WS_MIX = WS_VT + (size_t)512 * MPAD * 2;
constexpr size_t WS_H8 = WS_MIX + (size_t)MPAD * 1024 * 2;
constexpr size_t WS_WGU1_8 = WS_H8 + (size_t)MPAD * 1024, WS_WGU2_8 = WS_WGU1_8 + (size_t)2 * FF * D;
constexpr size_t WS_WD1_8 = WS_WGU2_8 + (size_t)2 * FF * D, WS_WD2_8 = WS_WD1_8 + (size_t)D * FF;
constexpr size_t WS_END = WS_WD2_8 + (size_t)D * FF;
constexpr size_t WS_HFFM = 128 * 1024;
constexpr float W8_SCALE = 64.0f, HFF8_SCALE = 8.0f, WD8_SCALE = 128.0f;
static_assert(WS_H + (size_t)MPAD * 2048 <= WS_BIG && WS_BIG + (size_t)MPAD * FF * 2 <= WS_H8, "ws map");
static_assert(WS_END <= 1024 * MiB, "ws map exceeds 1 GiB");

__device__ __forceinline__ unsigned cvt_pk_bf16(float lo, float hi) { unsigned r; asm volatile("v_cvt_pk_bf16_f32 %0, %1, %2" : "=v"(r) : "v"(lo), "v"(hi)); return r; }
typedef int i32x4 __attribute__((ext_vector_type(4)));
typedef int i32x8 __attribute__((ext_vector_type(8)));
__device__ __forceinline__ float clamp8(float v) { return __builtin_fminf(__builtin_fmaxf(v, -448.0f), 448.0f); }
__device__ __forceinline__ unsigned pk4_fp8(float a, float b, float c, float d) { int w = 0; w = __builtin_amdgcn_cvt_pk_fp8_f32(clamp8(a), clamp8(b), w, false); w = __builtin_amdgcn_cvt_pk_fp8_f32(clamp8(c), clamp8(d), w, true); return (unsigned)w; }
__device__ __forceinline__ float bf_lo(unsigned u) { return __uint_as_float(u << 16); }
__device__ __forceinline__ float bf_hi(unsigned u) { return __uint_as_float(u & 0xffff0000u); }
__device__ __forceinline__ float rstd_of(const unsigned long long* ssq, int row) { return rsqrtf((float)ssq[row] * (1.0f / (SSQ_SCALE * 1024.0f)) + EPS); }
__device__ __forceinline__ float wave_sum(float v) {
#pragma unroll
    for (int o = 1; o < 64; o <<= 1) v += __shfl_xor(v, o);
    return v;
}

namespace pg8 {
constexpr int BM = 256, BK = 64, HALF = 128, HTB = HALF * BK * 2, STAGE_BYTES = 8 * HTB, NXCD = 8, WGM = 8;
__host__ __device__ __forceinline__ int lds_byte(int r, int c) { const int st = (r >> 4) * 2 + (c >> 5), rr = r & 15, cc = c & 31, ob = rr * 64 + cc * 2; return st * 1024 + (ob ^ (((ob >> 9) & 1) << 5)); }
__host__ __device__ __forceinline__ void stage_rc(int b, int& R, int& C) { const int st = b / 1024, sb = b % 1024, swz = sb ^ (((sb >> 9) & 1) << 5); R = (st >> 1) * 16 + swz / 64; C = (st & 1) * 32 + (swz % 64) / 2; }
__host__ __device__ __forceinline__ int perm32(int rho) { const int n = rho >> 4, i = rho & 15; return 8 * (i >> 2) + 4 * n + (i & 3); }

struct Unit { int pm, pn; };
template <bool F8> struct FragSel { typedef bf16x8 type; };
template <> struct FragSel<true> { typedef i32x8 type; };
struct Gemm { const bf16_t* A; const bf16_t* Bt; int M, N, K; };

struct StaticOrder {
    int nM, nN, nwg, G, c;
    __host__ __device__ void init(int M, int N, int G_, int c_) { nM = M / BM; nN = N / BM; nwg = nM * nN; G = G_; c = c_; }
    __host__ __device__ bool next(int i, Unit& u) const {
        const long L = (long)i * G + c; if (L >= nwg) return false;
        int wgid = (int)L; { const int q = nwg / NXCD, r = nwg % NXCD, xcd = wgid % NXCD, off = wgid / NXCD; wgid = (xcd < r ? xcd * (q + 1) : r * (q + 1) + (xcd - r) * q) + off; }
        const int nig = WGM * nN, gid = wgid / nig, fm = gid * WGM, gsz = (nM - fm) < WGM ? (nM - fm) : WGM;
        u.pm = fm + ((wgid % nig) % gsz); u.pn = (wgid % nig) / gsz; return true;
    }
};

template <class Epi, class Sched, bool F8 = false>
__device__ __forceinline__ void gemm_phase(LAS unsigned char* lds, const Gemm g, const Sched& S, const Epi& E) {
    int tid = threadIdx.x; asm volatile("" : "+v"(tid));
    const int wid = __builtin_amdgcn_readfirstlane(tid >> 6), lane = tid & 63, wr = wid >> 2, wc = wid & 3, fr = lane & 15, fq = lane >> 4;
    using FragT = typename FragSel<F8>::type; constexpr int NKF = F8 ? 1 : 2;
    unsigned sc1 = 0x7F7F7F7Fu; asm volatile("" : "+v"(sc1));
    const int K = g.K, nt = K / BK;
    unsigned voffA[2], voffB[2];
#pragma unroll
    for (int i = 0; i < 2; ++i) { int R, C; stage_rc(tid * 16 + i * 8192, R, C); const int Rb = (R & ~31) + perm32(R & 31);
        voffA[i] = (unsigned)(R * K + C) * 2u; voffB[i] = (unsigned)(Rb * K + C) * 2u; }
    asm volatile("" : "+v"(voffA[0]), "+v"(voffA[1]), "+v"(voffB[0]), "+v"(voffB[1]));
    const size_t kstep = (size_t)(BK * 2);
    const size_t hstep = (size_t)HALF * K * 2;
    const size_t tstep = 2 * hstep;
    const unsigned ldsw = (unsigned)wid * 1024u;
    const int aoff = lds_byte(wr * 64 + fr, fq * 8), boff = lds_byte(wc * 32 + fr, fq * 8);
#define PG8_SA(b, h) (((b) * 2 + (h)) * HTB)
#define PG8_SB(b, h) ((4 + (b) * 2 + (h)) * HTB)
#define PG8_STAGE(bufoff, gbase, voff) do { _Pragma("unroll") for (int _i = 0; _i < 2; ++_i) \
        __builtin_amdgcn_global_load_lds((const unsigned*)((const char*)(gbase) + (voff)[_i]), (LAS unsigned*)(lds + (bufoff) + ldsw + _i * 8192), 16, 0, 0); } while (0)
#define PG8_LD1(dst, addr) do { if constexpr (F8) { dst[0] = __builtin_shufflevector(*(const LAS i32x4*)(addr), *(const LAS i32x4*)((addr) + 1024), 0, 1, 2, 3, 4, 5, 6, 7); } \
        else { _Pragma("unroll") for (int k = 0; k < NKF; ++k) dst[k] = *(const LAS FragT*)((addr) + k * 1024); } } while (0)
#define PG8_LDA(dst, b, h) do { _Pragma("unroll") for (int m = 0; m < 4; ++m) PG8_LD1(dst[m], lds + PG8_SA(b, h) + aoff + m * 2048); } while (0)
#define PG8_LDB(dst, b, h) do { _Pragma("unroll") for (int n = 0; n < 2; ++n) PG8_LD1(dst[n], lds + PG8_SB(b, h) + boff + n * 2048); } while (0)
#define PG8_MMA(ai, bj, At, Bt) do { __builtin_amdgcn_s_setprio(1); _Pragma("unroll") for (int m = 0; m < 4; ++m) _Pragma("unroll") for (int n = 0; n < 2; ++n) { \
        if constexpr (F8) { asm volatile("v_mfma_scale_f32_16x16x128_f8f6f4 %0, %1, %2, %0, %3, %3 op_sel_hi:[0,0,0]" : "+v"(acc[ai][bj][m][n]) : "v"(Bt[n][0]), "v"(At[m][0]), "v"(sc1)); } \
        else { _Pragma("unroll") for (int k = 0; k < 2; ++k) acc[ai][bj][m][n] = __builtin_amdgcn_mfma_f32_16x16x32_bf16(Bt[n][k], At[m][k], acc[ai][bj][m][n], 0, 0, 0); } } \
        __builtin_amdgcn_s_setprio(0); } while (0)
#define PG8_WAIT_V(n) asm volatile("s_waitcnt vmcnt(" #n ")" ::: "memory")
#define PG8_WAIT_L(n) asm volatile("s_waitcnt lgkmcnt(" #n ")" ::: "memory")
#define PG8_BAR __builtin_amdgcn_s_barrier()
#define PG8_SCHED __builtin_amdgcn_sched_barrier(0)
    Unit cur, nxt; int ui = 0;
    if (!S.next(0, cur)) return;
    f32x4 acc[2][2][4][2];
#pragma unroll
    for (int a = 0; a < 2; ++a)
#pragma unroll
        for (int b = 0; b < 2; ++b)
#pragma unroll
            for (int m = 0; m < 4; ++m)
#pragma unroll
                for (int n = 0; n < 2; ++n) acc[a][b][m][n] = (f32x4){0.f, 0.f, 0.f, 0.f};
    FragT At[4][NKF], B0[2][NKF], B1[2][NKF];
    unsigned long long pfv[8];
    const char* cA = (const char*)g.A + (size_t)cur.pm * tstep; const char* cB = (const char*)g.Bt + (size_t)cur.pn * tstep;
    PG8_STAGE(PG8_SB(0, 0), cB, voffB); PG8_STAGE(PG8_SB(0, 1), cB + hstep, voffB); PG8_STAGE(PG8_SA(0, 0), cA, voffA); PG8_STAGE(PG8_SA(0, 1), cA + hstep, voffA);
    if (wr == 1) PG8_BAR;
    PG8_WAIT_V(2); PG8_BAR;
    PG8_STAGE(PG8_SB(1, 0), cB + kstep, voffB); PG8_STAGE(PG8_SA(1, 0), cA + kstep, voffA); PG8_STAGE(PG8_SB(1, 1), cB + hstep + kstep, voffB);
    PG8_WAIT_V(6); PG8_BAR;
    for (;;) {
        const bool has_next = S.next(ui + 1, nxt);
        const char* nA = has_next ? (const char*)g.A + (size_t)nxt.pm * tstep : cA; const char* nB = has_next ? (const char*)g.Bt + (size_t)nxt.pn * tstep : cB;
#pragma unroll 1
        for (int t = 0; t < nt; t += 2) {
            const bool last = (t == nt - 2);
            if constexpr (Epi::PREF) { if (last) E.prefetch(pfv, cur, wr, fr); }
            const char* a1 = cA + (size_t)(t + 1) * kstep;
            const char* a2 = last ? nA : cA + (size_t)(t + 2) * kstep; const char* b2 = last ? nB : cB + (size_t)(t + 2) * kstep;
            const char* a3 = a2 + kstep; const char* b3 = b2 + kstep;
            PG8_LDB(B0, 0, 0); PG8_LDB(B1, 0, 1); PG8_SCHED; PG8_LDA(At, 0, 0); PG8_STAGE(PG8_SA(1, 1), a1 + hstep, voffA);
            PG8_WAIT_V(8); PG8_WAIT_L(0); PG8_BAR; PG8_MMA(0, 0, At, B0); PG8_MMA(0, 1, At, B1); PG8_BAR; PG8_SCHED;
            PG8_LDA(At, 0, 1); PG8_STAGE(PG8_SB(0, 0), b2, voffB); PG8_STAGE(PG8_SB(0, 1), b2 + hstep, voffB); PG8_STAGE(PG8_SA(0, 0), a2, voffA);
            PG8_WAIT_V(8); PG8_WAIT_L(0); PG8_BAR; PG8_MMA(1, 0, At, B0); PG8_MMA(1, 1, At, B1); PG8_BAR; PG8_SCHED;
            PG8_LDB(B0, 1, 0); PG8_LDB(B1, 1, 1); PG8_SCHED; PG8_LDA(At, 1, 0); PG8_STAGE(PG8_SA(0, 1), a2 + hstep, voffA);
            PG8_WAIT_V(8); PG8_WAIT_L(0); PG8_BAR; PG8_MMA(0, 0, At, B0); PG8_MMA(0, 1, At, B1); PG8_BAR; PG8_SCHED;
            PG8_LDA(At, 1, 1); PG8_STAGE(PG8_SB(1, 0), b3, voffB); PG8_STAGE(PG8_SB(1, 1), b3 + hstep, voffB); PG8_STAGE(PG8_SA(1, 0), a3, voffA);
            PG8_WAIT_V(8); PG8_WAIT_L(0); PG8_BAR; PG8_MMA(1, 0, At, B0); PG8_MMA(1, 1, At, B1); PG8_BAR; PG8_SCHED;
        }
        if (wr == 0) PG8_BAR;
        if constexpr (F8) { asm volatile("s_nop 15\n\ts_nop 7" ::: "memory"); PG8_SCHED; }
        if constexpr (Epi::PREF) E(acc, cur, wr, wc, fr, fq, pfv); else E(acc, cur, wr, wc, fr, fq);
        if (!has_next) break;
#pragma unroll
        for (int a = 0; a < 2; ++a)
#pragma unroll
            for (int b = 0; b < 2; ++b)
#pragma unroll
                for (int m = 0; m < 4; ++m)
#pragma unroll
                    for (int n = 0; n < 2; ++n) acc[a][b][m][n] = (f32x4){0.f, 0.f, 0.f, 0.f};
        cur = nxt; cA = nA; cB = nB; ++ui;
        if (wr == 1) PG8_BAR;
    }
    PG8_WAIT_V(0);
    PG8_BAR;
#undef PG8_SA
#undef PG8_SB
#undef PG8_STAGE
#undef PG8_LDA
#undef PG8_LD1
#undef PG8_LDB
#undef PG8_MMA
#undef PG8_WAIT_V
#undef PG8_WAIT_L
#undef PG8_BAR
#undef PG8_SCHED
}

__device__ __forceinline__ float silu_mul(float g, float u) { return g * __builtin_amdgcn_rcpf(1.0f + __builtin_amdgcn_exp2f(-g * LOG2E)) * u; }
struct EpiGateUp {
    static constexpr bool PREF = true;
    unsigned char* O; const unsigned long long* ssq; float wsc;
    __device__ __forceinline__ void prefetch(unsigned long long (&pf)[8], const Unit& u, int wr, int fr) const {
        const int row0 = u.pm * BM + wr * 64 + fr;
#pragma unroll
        for (int ai = 0; ai < 2; ++ai)
#pragma unroll
            for (int m = 0; m < 4; ++m) pf[ai * 4 + m] = ssq[row0 + ai * HALF + m * 16];
    }
    __device__ __forceinline__ void operator()(const f32x4 (&acc)[2][2][4][2], const Unit& u, int wr, int wc, int fr, int fq, const unsigned long long (&pf)[8]) const {
        const int row0 = u.pm * BM + wr * 64 + fr, col0 = u.pn * HALF + wc * 32 + 8 * fq;
#pragma unroll
        for (int ai = 0; ai < 2; ++ai)
#pragma unroll
            for (int m = 0; m < 4; ++m) { const int row = row0 + ai * HALF + m * 16; const float rs = rsqrtf((float)pf[ai * 4 + m] * (1.0f / (SSQ_SCALE * 1024.0f)) + EPS) * wsc;
                const f32x4 g0 = acc[ai][0][m][0] * rs, g1 = acc[ai][0][m][1] * rs, u0 = acc[ai][1][m][0] * rs, u1 = acc[ai][1][m][1] * rs;
                u32x2 w; w.x = pk4_fp8(silu_mul(g0[0], u0[0]) * HFF8_SCALE, silu_mul(g0[1], u0[1]) * HFF8_SCALE, silu_mul(g0[2], u0[2]) * HFF8_SCALE, silu_mul(g0[3], u0[3]) * HFF8_SCALE);
                w.y = pk4_fp8(silu_mul(g1[0], u1[0]) * HFF8_SCALE, silu_mul(g1[1], u1[1]) * HFF8_SCALE, silu_mul(g1[2], u1[2]) * HFF8_SCALE, silu_mul(g1[3], u1[3]) * HFF8_SCALE);
                *(u32x2*)(O + (size_t)row * FF + col0) = w; }
    }
};
struct EpiResid {
    static constexpr bool PREF = false;
    bf16_t* H; unsigned long long* ssq_out; unsigned char* H8; float asc;
    __device__ __forceinline__ void operator()(const f32x4 (&acc)[2][2][4][2], const Unit& u, int wr, int wc, int fr, int fq) const {
        const int row0 = u.pm * BM + wr * 64 + fr, col0 = u.pn * BM + wc * 32 + 8 * fq;
#pragma unroll
        for (int ai = 0; ai < 2; ++ai)
#pragma unroll
            for (int m = 0; m < 4; ++m) { const int row = row0 + ai * HALF + m * 16; float ss = 0.f;
#pragma unroll
                for (int bj = 0; bj < 2; ++bj) { bf16_t* p = H + (size_t)row * D + col0 + bj * HALF; const u32x4 hv = *(const u32x4*)p;
                    const f32x4 a0 = acc[ai][bj][m][0] * asc, a1 = acc[ai][bj][m][1] * asc;
                    const float v0 = bf_lo(hv.x) + a0[0], v1 = bf_hi(hv.x) + a0[1], v2 = bf_lo(hv.y) + a0[2], v3 = bf_hi(hv.y) + a0[3];
                    const float v4 = bf_lo(hv.z) + a1[0], v5 = bf_hi(hv.z) + a1[1], v6 = bf_lo(hv.w) + a1[2], v7 = bf_hi(hv.w) + a1[3];
                    ss += (v0 * v0 + v1 * v1) + (v2 * v2 + v3 * v3) + (v4 * v4 + v5 * v5) + (v6 * v6 + v7 * v7);
                    u32x4 w; w.x = cvt_pk_bf16(v0, v1); w.y = cvt_pk_bf16(v2, v3); w.z = cvt_pk_bf16(v4, v5); w.w = cvt_pk_bf16(v6, v7);
                    *(u32x4*)p = w;
                    if (H8) { u32x2 w8; w8.x = pk4_fp8(v0, v1, v2, v3); w8.y = pk4_fp8(v4, v5, v6, v7); *(u32x2*)(H8 + (size_t)row * D + col0 + bj * HALF) = w8; } }
                ss += __shfl_xor(ss, 16); ss += __shfl_xor(ss, 32);
                if (fq == 0) atomicAdd(ssq_out + row, (unsigned long long)(ss * SSQ_SCALE + 0.5f)); }
    }
};
struct EpiRowScale {
    static constexpr bool PREF = false;
    bf16_t* O; int ldc; const unsigned long long* ssq;
    __device__ __forceinline__ void operator()(const f32x4 (&acc)[2][2][4][2], const Unit& u, int wr, int wc, int fr, int fq) const {
        const int row0 = u.pm * BM + wr * 64 + fr, col0 = u.pn * BM + wc * 32 + 8 * fq;
#pragma unroll
        for (int ai = 0; ai < 2; ++ai)
#pragma unroll
            for (int m = 0; m < 4; ++m) { const int row = row0 + ai * HALF + m * 16; const float rs = rstd_of(ssq, row);
#pragma unroll
                for (int bj = 0; bj < 2; ++bj) { const f32x4 v0 = acc[ai][bj][m][0] * rs, v1 = acc[ai][bj][m][1] * rs;
                    u32x4 w; w.x = cvt_pk_bf16(v0[0], v0[1]); w.y = cvt_pk_bf16(v0[2], v0[3]); w.z = cvt_pk_bf16(v1[0], v1[1]); w.w = cvt_pk_bf16(v1[2], v1[3]);
                    *(u32x4*)(O + (size_t)row * ldc + col0 + bj * HALF) = w; } }
    }
};
struct EpiColScale {
    static constexpr bool PREF = false;
    bf16_t* O; int ldc; const unsigned long long* ssq;
    __device__ __forceinline__ void operator()(const f32x4 (&acc)[2][2][4][2], const Unit& u, int wr, int wc, int fr, int fq) const {
        const int row0 = u.pm * BM + wr * 64 + fr, col0 = u.pn * BM + wc * 32 + 8 * fq;
#pragma unroll
        for (int bj = 0; bj < 2; ++bj) {
            float rs[8];
#pragma unroll
            for (int j = 0; j < 8; ++j) rs[j] = rstd_of(ssq, col0 + bj * HALF + j);
#pragma unroll
            for (int ai = 0; ai < 2; ++ai)
#pragma unroll
                for (int m = 0; m < 4; ++m) { const int row = row0 + ai * HALF + m * 16; const f32x4 v0 = acc[ai][bj][m][0], v1 = acc[ai][bj][m][1];
                    u32x4 w; w.x = cvt_pk_bf16(v0[0] * rs[0], v0[1] * rs[1]); w.y = cvt_pk_bf16(v0[2] * rs[2], v0[3] * rs[3]);
                    w.z = cvt_pk_bf16(v1[0] * rs[4], v1[1] * rs[5]); w.w = cvt_pk_bf16(v1[2] * rs[6], v1[3] * rs[7]);
                    *(u32x4*)(O + (size_t)row * ldc + col0 + bj * HALF) = w; }
        }
    }
};
}

template <int MODE>
__device__ __forceinline__ void tr2_item(const float* __restrict__ W, int ldw, int k0, int n0, bf16_t* __restrict__ WT, unsigned char* __restrict__ WT8, int ldt, int dst_row0, int dst_k0,
                                         const float* __restrict__ ks, float cs, float cs8, LAS float* scr, int lane) {
    f32x4 v[16];
#pragma unroll
    for (int i = 0; i < 16; ++i) { const int r = 2 * i + (lane >> 5); v[i] = *(const f32x4*)(W + (size_t)(k0 + r) * ldw + n0 + (lane & 31) * 4); }
#pragma unroll
    for (int i = 0; i < 16; ++i) { const int r = 2 * i + (lane >> 5); const float sc = ks ? ks[k0 + r] : 1.0f; LAS float* d = scr + r * 129 + (lane & 31) * 4;
        d[0] = v[i].x * sc; d[1] = v[i].y * sc; d[2] = v[i].z * sc; d[3] = v[i].w * sc; }
    asm volatile("s_waitcnt lgkmcnt(0)" ::: "memory");
    if constexpr (MODE != 0) { const int c = lane & 1;
#pragma unroll
        for (int j = 0; j < 4; ++j) { const int n = (lane >> 1) + 32 * j; const LAS float* s = scr + (16 * c) * 129 + n;
            u32x4 o; o.x = pk4_fp8(s[0 * 129] * cs8, s[1 * 129] * cs8, s[2 * 129] * cs8, s[3 * 129] * cs8); o.y = pk4_fp8(s[4 * 129] * cs8, s[5 * 129] * cs8, s[6 * 129] * cs8, s[7 * 129] * cs8);
            o.z = pk4_fp8(s[8 * 129] * cs8, s[9 * 129] * cs8, s[10 * 129] * cs8, s[11 * 129] * cs8); o.w = pk4_fp8(s[12 * 129] * cs8, s[13 * 129] * cs8, s[14 * 129] * cs8, s[15 * 129] * cs8);
            *(u32x4*)(WT8 + (size_t)(dst_row0 + n) * ldt + dst_k0 + k0 + 16 * c) = o; }
    }
    if constexpr (MODE != 1) { const int c = lane & 3;
#pragma unroll
        for (int j = 0; j < 8; ++j) { const int n = (lane >> 2) + 16 * j; const LAS float* s = scr + (8 * c) * 129 + n;
            u32x4 o; o.x = cvt_pk_bf16(s[0 * 129] * cs, s[1 * 129] * cs); o.y = cvt_pk_bf16(s[2 * 129] * cs, s[3 * 129] * cs); o.z = cvt_pk_bf16(s[4 * 129] * cs, s[5 * 129] * cs); o.w = cvt_pk_bf16(s[6 * 129] * cs, s[7 * 129] * cs);
            *(u32x4*)(WT + (size_t)(dst_row0 + n) * ldt + dst_k0 + k0 + 8 * c) = o; }
    }
    asm volatile("s_waitcnt lgkmcnt(0)" ::: "memory");
}

struct Args { const float* in[23]; float* out; unsigned char* ws; int ph_lo, ph_hi; };

__device__ __forceinline__ void prologue(const Args& a, LAS unsigned char* lds, int gw, int NGW, int lane, int wave) {
    asm volatile("" : "+v"(lane));
    unsigned char* ws = a.ws;
    LAS float* scr = (LAS float*)(lds + wave * 16512);
    bf16_t* WGU1 = (bf16_t*)(ws + WS_WGU1); bf16_t* WD1 = (bf16_t*)(ws + WS_WD1); bf16_t* WIN = (bf16_t*)(ws + WS_WIN); bf16_t* WOUT = (bf16_t*)(ws + WS_WOUT);
    constexpr int I_GU = (D / 32) * (FF / 128), I_DN = (FF / 32) * (D / 128), I_IN = (D / 32) * (2048 / 128), I_OUT = (512 / 32) * (D / 128);
    constexpr int NITEMS = 6 * I_GU + I_IN + I_OUT;
    static_assert(I_GU == I_DN, "item counts");
#ifdef PROBE_DUP_W
    for (int rep_ = 0; rep_ < 2; ++rep_)
#endif
    for (int it = gw; it < NITEMS; it += NGW) {
        int r = it;
        if (r < 6 * I_GU) {
            const int which = r / I_GU; r -= which * I_GU; const int layer = which / 3, kind = which % 3;
            if (kind < 2) { const int nblk = FF / 128, kb = r / nblk, nb = r % nblk, n0 = nb * 128; const int drow = nb * 256 + kind * 128;
                if (layer) tr2_item<1>(a.in[19 + kind], FF, kb * 32, n0, nullptr, ws + WS_WGU2_8, D, drow, 0, a.in[18], 1.0f, W8_SCALE, scr, lane);
                else tr2_item<2>(a.in[5 + kind], FF, kb * 32, n0, WGU1, ws + WS_WGU1_8, D, drow, 0, a.in[4], 1.0f, W8_SCALE, scr, lane);
            } else { const int nblk = D / 128, kb = r / nblk, nb = r % nblk, n0 = nb * 128;
                if (layer) tr2_item<1>(a.in[21], D, kb * 32, n0, nullptr, ws + WS_WD2_8, FF, n0, 0, nullptr, 0.5f, 0.5f * WD8_SCALE, scr, lane);
                else tr2_item<2>(a.in[7], D, kb * 32, n0, WD1, ws + WS_WD1_8, FF, n0, 0, nullptr, 0.5f, 0.5f * WD8_SCALE, scr, lane); }
            continue;
        }
        r -= 6 * I_GU;
        if (r < I_IN) { const int nblk = 2048 / 128, kb = r / nblk, nb = r % nblk, n0 = nb * 128;
            const int drow = n0 < 1024 ? n0 : (n0 < 1536 ? n0 + 512 : n0 - 512);
            tr2_item<0>(a.in[9], 2048, kb * 32, n0, WIN, nullptr, D, drow, 0, a.in[8], n0 < 512 ? C2 : 1.0f, 0.f, scr, lane); continue; }
        r -= I_IN;
        { const int nblk = D / 128, kb = r / nblk, nb = r % nblk, n0 = nb * 128;
          tr2_item<0>(a.in[17], D, kb * 32, n0, WOUT, nullptr, D, n0, 0, nullptr, 1.0f, 0.f, scr, lane); }
    }
    for (int it = gw; it < 2048; it += NGW) {
        const int g = it >> 9, nb = (it >> 5) & 15, cb = it & 31, n = nb * 64 + lane;
        const float* pw = a.in[15] + (size_t)(g * 128 + cb * 4) * 128; const float* ps = a.in[16] + g * 128; const float* wo = a.in[17] + (size_t)(512 + g * 128) * D + n;
        float acc[4] = {0.f, 0.f, 0.f, 0.f};
#pragma unroll 32
        for (int d = 0; d < 128; ++d) { const float w = wo[(size_t)d * D] * ps[d];
#pragma unroll
            for (int c = 0; c < 4; ++c) acc[c] += pw[c * 128 + d] * w; }
        u32x2 o0; o0.x = cvt_pk_bf16(acc[0], acc[1]); o0.y = cvt_pk_bf16(acc[2], acc[3]);
        *(u32x2*)(WOUT + (size_t)n * D + 512 + g * 128 + cb * 4) = o0;
    }
    bf16_t* H = (bf16_t*)(ws + WS_H); unsigned long long* SSQ = (unsigned long long*)(ws + WS_SSQ);
    for (int row0 = gw * 4; row0 < MPAD; row0 += NGW * 4) {
        f32x4 v[4][4];
#pragma unroll
        for (int i = 0; i < 4; ++i) { const int row = row0 + i;
            if (row < NREAL + NMETA) { const float* src = row < NB1 * S1 ? a.in[0] + (size_t)row * D : (row < NREAL ? a.in[1] + (size_t)(row - NB1 * S1) * D : a.in[2] + (size_t)(row - NREAL) * D);
#pragma unroll
                for (int j = 0; j < 4; ++j) v[i][j] = ((const f32x4*)src)[lane + 64 * j];
            } else {
#pragma unroll
                for (int j = 0; j < 4; ++j) v[i][j] = (f32x4){0.f, 0.f, 0.f, 0.f};
            } }
#pragma unroll
        for (int i = 0; i < 4; ++i) { const int row = row0 + i; float s = 0.f;
#pragma unroll
            for (int j = 0; j < 4; ++j) s += (v[i][j].x * v[i][j].x + v[i][j].y * v[i][j].y) + (v[i][j].z * v[i][j].z + v[i][j].w * v[i][j].w);
            s = wave_sum(s);
            u32x2* o8 = (u32x2*)(H + (size_t)row * D) + lane;
#pragma unroll
            for (int j = 0; j < 4; ++j) { u32x2 w; w.x = cvt_pk_bf16(v[i][j].x, v[i][j].y); w.y = cvt_pk_bf16(v[i][j].z, v[i][j].w); o8[64 * j] = w;
                ((unsigned*)(ws + WS_H8 + (size_t)row * D))[lane + 64 * j] = pk4_fp8(v[i][j].x, v[i][j].y, v[i][j].z, v[i][j].w); }
            if (lane == 0) { SSQ[row] = (unsigned long long)(s * SSQ_SCALE + 0.5f); SSQ[131072 + row] = 0ull; SSQ[2 * 131072 + row] = 0ull; SSQ[3 * 131072 + row] = 0ull; } }
    }
    if (gw == 0 && lane < 16) ((unsigned*)(ws + WS_CTL))[lane * 64] = 0u;
    {
        static_assert((size_t)NREAL * FF <= (size_t)(META0 + NMETA) * 1536 * 2, "hff (fp8, real rows only) must end below the zeroed U3 rows");
        bf16_t* U3z = (bf16_t*)(ws + WS_U3) + (size_t)(META0 + NMETA) * 1536; bf16_t* VTz = (bf16_t*)(ws + WS_VT) + META0 + NMETA;
        const u32x4 z4 = (u32x4){0u, 0u, 0u, 0u};
        for (int i = gw * 64 + lane; i < 48 * 1536 / 8; i += NGW * 64) *(u32x4*)(U3z + (size_t)i * 8) = z4;
        for (int i = gw * 64 + lane; i < 512 * 6; i += NGW * 64) *(u32x4*)(VTz + (size_t)(i / 6) * MPAD + (i % 6) * 8) = z4;
    }
}

__device__ __forceinline__ void pool_acc(float (&sum)[8], const u32x4 x, float sgn) {
    sum[0] += sgn * bf_lo(x.x); sum[1] += sgn * bf_hi(x.x); sum[2] += sgn * bf_lo(x.y); sum[3] += sgn * bf_hi(x.y);
    sum[4] += sgn * bf_lo(x.z); sum[5] += sgn * bf_hi(x.z); sum[6] += sgn * bf_lo(x.w); sum[7] += sgn * bf_hi(x.w); }
__device__ __forceinline__ void pool_phase(const bf16_t* __restrict__ U3, bf16_t* __restrict__ MIX, int gw, int NGW, int lane) {
    asm volatile("" : "+v"(lane));
    constexpr int NTASK = NREAL / 8;
    const int g = lane >> 4, w2 = 1 << g, col = lane * 8;
    const u32x4 z4 = (u32x4){0u, 0u, 0u, 0u};
    const bf16_t* xcol = U3 + 1024 + col;
    for (int task = gw; task < NTASK; task += NGW) {
        const int r0 = task * 8; int seqbase, L;
        if (r0 < NB1 * S1) { seqbase = r0 & ~(S1 - 1); L = L1; } else { seqbase = NB1 * S1 + ((r0 - NB1 * S1) & ~(S2 - 1)); L = L2; }
        const int t0 = r0 - seqbase + NMETA;
#define XROW(tt) (xcol + (size_t)((tt) < NMETA ? META0 + (tt) : seqbase + (tt) - NMETA) * 1536)
        u32x4 wv[16];
#pragma unroll
        for (int j = 0; j < 16; ++j) { const int tt = t0 - 8 + j; wv[j] = (j >= 8 - w2 && j < 8 + w2 && tt >= 0 && tt < L) ? *(const u32x4*)XROW(tt) : z4; }
        float sum[8];
#pragma unroll
        for (int e = 0; e < 8; ++e) sum[e] = 0.f;
#pragma unroll
        for (int j = 0; j < 16; ++j) pool_acc(sum, wv[j], 1.0f);
        u32x4 xc[8], xa[8], xs[8];
#pragma unroll
        for (int i = 0; i < 8; ++i) { const int t = t0 + i; xc[i] = *(const u32x4*)XROW(t);
            xa[i] = (t + w2 < L) ? *(const u32x4*)XROW(t + w2) : z4; xs[i] = (t - w2 >= 0) ? *(const u32x4*)XROW(t - w2) : z4; }
#pragma unroll
        for (int i = 0; i < 8; ++i) { const int t = t0 + i; const int lo = max(t - w2, 0), hi = min(t + w2, L); const float inv = 1.0f / (float)(hi - lo);
            const u32x4 x = xc[i];
            u32x4 o; o.x = cvt_pk_bf16(sum[0] * inv - bf_lo(x.x), sum[1] * inv - bf_hi(x.x)); o.y = cvt_pk_bf16(sum[2] * inv - bf_lo(x.y), sum[3] * inv - bf_hi(x.y));
            o.z = cvt_pk_bf16(sum[4] * inv - bf_lo(x.z), sum[5] * inv - bf_hi(x.z)); o.w = cvt_pk_bf16(sum[6] * inv - bf_lo(x.w), sum[7] * inv - bf_hi(x.w));
            *(u32x4*)(MIX + (size_t)(r0 + i) * D + 512 + col) = o;
            pool_acc(sum, xa[i], 1.0f); pool_acc(sum, xs[i], -1.0f); }
    }
#undef XROW
}

namespace att {
constexpr int STAGE = 32768;
constexpr int LDS_COMB = 0;
constexpr int LDS_LUT = 131072;
constexpr int LDS_MISC = 131072 + 2048;
constexpr float NEG = -1.0e30f;
constexpr int UNITS_PER_Q = 4 * 64 + 8 * 16;

__device__ __forceinline__ unsigned cvtpk(float lo, float hi) { typedef float f2 __attribute__((ext_vector_type(2))); typedef __bf16 b2 __attribute__((ext_vector_type(2)));
    f2 v = {lo, hi}; b2 b = __builtin_convertvector(v, b2); return __builtin_bit_cast(unsigned, b); }

__device__ __forceinline__ void attn_unit(LAS unsigned char* lds, const bf16_t* __restrict__ U3, const bf16_t* __restrict__ VT, bf16_t* __restrict__ MIX,
                                          const float* __restrict__ tbl, const float* __restrict__ gain, float lam, int grp, int b, int h, int qb) {
    int tid = threadIdx.x; asm volatile("" : "+v"(tid));
    const int lane = tid & 63, r32 = lane & 31, hi = lane >> 5;
    const int w = __builtin_amdgcn_readfirstlane(tid >> 6), c = w >> 2;
    const int S = grp ? S2 : S1, rowbase = grp ? NB1 * S1 + b * S2 : b * S1, NT = (S >> 6) + 1;
    const int qw0 = NMETA + qb * 128 + (w & 3) * 32, q = qw0 + r32;
    LAS float* lut = (LAS float*)(lds + LDS_LUT);
    if (tid < 257) { const int rel = tid - 128, n = rel < 0 ? -rel : rel;
        int bk = n < 8 ? n : 8 + (n >= 12) + (n >= 16) + (n >= 23) + (n >= 32) + (n >= 46) + (n >= 64) + (n >= 91);
        if (rel > 0) bk += 16;
        lut[tid] = tbl[bk * 4 + h] * LOG2E; }
    bf16x8 qr[4];
    { const bf16_t* qp = U3 + (size_t)(rowbase + q - NMETA) * 1536 + h * 128 + c * 64 + hi * 8;
#pragma unroll
      for (int d0 = 0; d0 < 4; ++d0) qr[d0] = *(const bf16x8*)(qp + d0 * 16); }
    const bf16_t* kg[2]; const bf16_t* vg[2];
#pragma unroll
    for (int i = 0; i < 2; ++i) { const int row = 4 * (i * 8 + w) + (lane >> 4), kch = (lane & 15) ^ (row & 15);
        kg[i] = U3 + (size_t)row * 1536 + 512 + h * 128 + kch * 8;
        const int rp = row, p = (lane & 15) ^ (rp & 15), dv = 2 * rp + (p >> 3), ch = p & 7;
        vg[i] = VT + (size_t)(h * 128 + dv) * MPAD + ch * 8; }
#define ATT_DMA(T, SLOT) do { LAS unsigned char* sb_ = lds + (SLOT) * STAGE + w * 1024; const int tr_ = ((T) < NT - 1) ? rowbase + (T) * 64 : META0; \
        __builtin_amdgcn_global_load_lds((const unsigned*)(kg[0] + (size_t)tr_ * 1536), (LAS unsigned*)(sb_), 16, 0, 0); \
        __builtin_amdgcn_global_load_lds((const unsigned*)(kg[1] + (size_t)tr_ * 1536), (LAS unsigned*)(sb_ + 8192), 16, 0, 0); \
        __builtin_amdgcn_global_load_lds((const unsigned*)(vg[0] + tr_), (LAS unsigned*)(sb_ + 16384), 16, 0, 0); \
        __builtin_amdgcn_global_load_lds((const unsigned*)(vg[1] + tr_), (LAS unsigned*)(sb_ + 24576), 16, 0, 0); } while (0)
    const int pi = (r32 & 0x13) | ((r32 & 4) << 1) | ((r32 & 8) >> 1);
    unsigned koff[4], voff[4];
#pragma unroll
    for (int d0 = 0; d0 < 4; ++d0) koff[d0] = pi * 256 + (((c * 8 + d0 * 2 + hi) ^ (pi & 15)) << 4);
#pragma unroll
    for (int j = 0; j < 4; ++j) voff[j] = 16384 + (r32 >> 1) * 256 + (((((r32 & 1) << 3) + 2 * j + hi) ^ (r32 >> 1)) << 4);

    ATT_DMA(0, 0); ATT_DMA(1, 1);
    asm volatile("s_waitcnt vmcnt(4)" ::: "memory");
    asm volatile("s_waitcnt lgkmcnt(0)" ::: "memory"); __builtin_amdgcn_s_barrier(); asm volatile("" ::: "memory");
    const float bL = lut[0], bR = lut[256];
    f32x16 o[4];
#pragma unroll
    for (int d0 = 0; d0 < 4; ++d0)
#pragma unroll
        for (int r = 0; r < 16; ++r) o[d0][r] = 0.f;
    float mhat = 0.f, l = 0.f;
    bf16x8 pf[4];
#pragma unroll
    for (int j = 0; j < 4; ++j) pf[j] = (bf16x8){0, 0, 0, 0, 0, 0, 0, 0};
    int slot = 0, slotp = 0, slot2 = 2;
#define SBAR() __builtin_amdgcn_sched_barrier(0)
#define EXP2(P, R) do { P[R] = __builtin_amdgcn_exp2f(P[R]); P[(R) + 1] = __builtin_amdgcn_exp2f(P[(R) + 1]); ssum += P[R]; ssum += P[(R) + 1]; asm volatile("" : "+v"(P), "+v"(ssum)); } while (0)
#define CVT8(P, B, J) do { u32x4 x_; x_.x = cvtpk(P[B], P[(B) + 1]); x_.y = cvtpk(P[(B) + 2], P[(B) + 3]); x_.z = cvtpk(P[(B) + 4], P[(B) + 5]); x_.w = cvtpk(P[(B) + 6], P[(B) + 7]); pf[J] = __builtin_bit_cast(bf16x8, x_); asm volatile("" : "+v"(pf[J])); } while (0)
#define VRD(J) do { _Pragma("unroll") for (int d0_ = 0; d0_ < 4; ++d0_) vf[(J) & 1][d0_] = *(const LAS bf16x8*)(pbuf + voff[J] + d0_ * 4096); } while (0)
#define PVM(J, D0) do { __builtin_amdgcn_s_setprio(1); o[D0] = __builtin_amdgcn_mfma_f32_32x32x16_bf16(vf[(J) & 1][D0], pf[J], o[D0], 0, 0, 0); __builtin_amdgcn_s_setprio(0); } while (0)
#define ATT_SCORES() do { \
        const float ci_ = (slow ? 0.f : (farl ? bL : bR)) - mhat; \
        _Pragma("unroll") for (int r = 0; r < 16; ++r) { p0[r] = ci_; p1[r] = ci_; } \
        { bf16x8 ka[4], kb[4]; \
          _Pragma("unroll") for (int d0 = 0; d0 < 4; ++d0) { ka[d0] = *(const LAS bf16x8*)(buf + koff[d0]); kb[d0] = *(const LAS bf16x8*)(buf + koff[d0] + 8192); } \
          SBAR(); \
          __builtin_amdgcn_s_setprio(1); \
          _Pragma("unroll") for (int d0 = 0; d0 < 4; ++d0) { p0 = __builtin_amdgcn_mfma_f32_32x32x16_bf16(ka[d0], qr[d0], p0, 0, 0, 0); p1 = __builtin_amdgcn_mfma_f32_32x32x16_bf16(kb[d0], qr[d0], p1, 0, 0, 0); } \
          __builtin_amdgcn_s_setprio(0); } \
        if (slow) { \
            _Pragma("unroll") for (int r = 0; r < 16; ++r) { const int kv = k0 + (r & 7) + 8 * hi + 16 * (r >> 3); const int rel = kv - q; \
                p0[r] += lut[min(max(rel, -128), 128) + 128]; p1[r] += lut[min(max(rel + 32, -128), 128) + 128]; \
                if (mt) { if (kv >= NMETA) p0[r] = NEG; p1[r] = NEG; } } \
        } \
    } while (0)
#pragma unroll 1
    for (int t = 0; t < NT; ++t) {
        const bool mt = (t == NT - 1); const int k0 = mt ? 0 : NMETA + t * 64; LAS unsigned char* buf = lds + slot * STAGE; LAS unsigned char* pbuf = lds + slotp * STAGE;
        const bool ahead = t + 2 < NT;
        if (ahead) ATT_DMA(t + 2, slot2);
        const int relmax = k0 + 63 - qw0, relmin = k0 - (qw0 + 31);
        const bool farl = relmax <= -91, farr = relmin >= 91;
        const bool slow = !(farl || farr) || mt;
        f32x16 p0, p1;
        ATT_SCORES();
        bf16x8 vf[2][4];
        VRD(0);
        float ssum = 0.f;
        if (t != 0) {
        SBAR();
        VRD(1); SBAR(); PVM(0, 0); EXP2(p0, 0); SBAR(); PVM(0, 1); EXP2(p0, 2); SBAR(); PVM(0, 2); EXP2(p0, 4); SBAR(); PVM(0, 3); EXP2(p0, 6); SBAR();
        VRD(2); SBAR(); PVM(1, 0); EXP2(p0, 8); CVT8(p0, 0, 0); SBAR(); PVM(1, 1); EXP2(p0, 10); SBAR(); PVM(1, 2); EXP2(p0, 12); SBAR(); PVM(1, 3); EXP2(p0, 14); SBAR();
        VRD(3); SBAR(); PVM(2, 0); EXP2(p1, 0); CVT8(p0, 8, 1); SBAR(); PVM(2, 1); EXP2(p1, 2); SBAR(); PVM(2, 2); EXP2(p1, 4); SBAR(); PVM(2, 3); EXP2(p1, 6); SBAR();
        PVM(3, 0); EXP2(p1, 8); CVT8(p1, 0, 2); SBAR(); PVM(3, 1); EXP2(p1, 10); SBAR(); PVM(3, 2); EXP2(p1, 12); SBAR(); PVM(3, 3); EXP2(p1, 14); SBAR();
        CVT8(p1, 8, 3);
        }
        if (t == 0 || __any(!(ssum <= 8192.0f))) {
            if (t != 0) ATT_SCORES();
            float rma = __builtin_fmaxf(__builtin_fmaxf(p0[0], p0[1]), p1[0]), rmb = __builtin_fmaxf(__builtin_fmaxf(p0[2], p0[3]), p1[1]);
            rma = __builtin_fmaxf(__builtin_fmaxf(rma, p1[2]), p1[3]);
#pragma unroll
            for (int r = 4; r < 16; r += 4) { rma = __builtin_fmaxf(__builtin_fmaxf(rma, p0[r]), p0[r + 1]); rmb = __builtin_fmaxf(__builtin_fmaxf(rmb, p0[r + 2]), p0[r + 3]);
                rma = __builtin_fmaxf(__builtin_fmaxf(rma, p1[r]), p1[r + 1]); rmb = __builtin_fmaxf(__builtin_fmaxf(rmb, p1[r + 2]), p1[r + 3]); }
            float rm = __builtin_fmaxf(rma, rmb);
            { auto rr = __builtin_amdgcn_permlane32_swap(__float_as_uint(rm), __float_as_uint(rm), false, false); rm = __builtin_fmaxf(__uint_as_float(rr[0]), __uint_as_float(rr[1])); }
            const float dl = (t == 0) ? rm : fmaxf(rm, 0.f); mhat += dl;
            if (t != 0) { const float fsc = __builtin_amdgcn_exp2f(-dl); l *= fsc;
#pragma unroll
                for (int d0 = 0; d0 < 4; ++d0)
#pragma unroll
                    for (int r = 0; r < 16; ++r) o[d0][r] *= fsc; }
            ssum = 0.f;
#pragma unroll
            for (int r = 0; r < 16; ++r) { p0[r] = __builtin_amdgcn_exp2f(p0[r] - dl); p1[r] = __builtin_amdgcn_exp2f(p1[r] - dl); ssum += p0[r]; ssum += p1[r]; }
            CVT8(p0, 0, 0); CVT8(p0, 8, 1); CVT8(p1, 0, 2); CVT8(p1, 8, 3);
        }
        l += ssum;
        if (ahead) asm volatile("s_waitcnt vmcnt(4)" ::: "memory"); else asm volatile("s_waitcnt vmcnt(0)" ::: "memory");
        asm volatile("s_waitcnt lgkmcnt(0)" ::: "memory"); __builtin_amdgcn_s_barrier(); asm volatile("" ::: "memory");
        slotp = slot; slot = (slot + 1) & 3; slot2 = (slot2 + 1) & 3;
    }
#undef ATT_SCORES
    {
        LAS unsigned char* pbuf = lds + slotp * STAGE; bf16x8 vf[2][4];
        VRD(0);
#pragma unroll
        for (int j = 0; j < 4; ++j) { if (j < 3) VRD((j + 1) & 3); SBAR();
#pragma unroll
            for (int d0 = 0; d0 < 4; ++d0) PVM(j, d0);
            SBAR(); }
    }
    asm volatile("s_waitcnt lgkmcnt(0)" ::: "memory"); __builtin_amdgcn_s_barrier(); asm volatile("" ::: "memory");
#undef SBAR
#undef EXP2
#undef CVT8
#undef VRD
#undef PVM
#undef ATT_DMA
    l += __shfl_xor(l, 32);
    const float inv = 1.0f / l;
    LAS float* comb = (LAS float*)(lds + LDS_COMB) + (w & 3) * 4096 + r32;
    if (c == 1) { const float sc = lam * inv;
#pragma unroll
        for (int d0 = 0; d0 < 4; ++d0)
#pragma unroll
            for (int r = 0; r < 16; ++r) comb[(32 * d0 + (r & 3) + 8 * (r >> 2) + 4 * hi) * 32] = o[d0][r] * sc; }
    __syncthreads();
    if (c == 0) { float ss = 0.f;
#pragma unroll
        for (int d0 = 0; d0 < 4; ++d0)
#pragma unroll
            for (int r = 0; r < 16; ++r) { const float v = o[d0][r] * inv - comb[(32 * d0 + (r & 3) + 8 * (r >> 2) + 4 * hi) * 32]; o[d0][r] = v; ss += v * v; }
        ss += __shfl_xor(ss, 32);
        const float rs = rsqrtf(ss * (1.0f / 128.0f) + EPS) * 0.8f;
        {
            LAS unsigned char* stg = lds + 65536 + (w & 3) * 8704;
#pragma unroll
            for (int d0 = 0; d0 < 4; ++d0)
#pragma unroll
                for (int rg = 0; rg < 4; ++rg) { const int dv = 32 * d0 + 8 * rg; const f32x4 gn = *(const f32x4*)(gain + dv + 4 * hi);
                    u32x2 wv; wv.x = cvt_pk_bf16(o[d0][4 * rg] * rs * gn.x, o[d0][4 * rg + 1] * rs * gn.y); wv.y = cvt_pk_bf16(o[d0][4 * rg + 2] * rs * gn.z, o[d0][4 * rg + 3] * rs * gn.w);
                    *(LAS u32x2*)(stg + r32 * 272 + (dv + 4 * hi) * 2) = wv; }
            asm volatile("s_waitcnt lgkmcnt(0)" ::: "memory");
            bf16_t* op = MIX + (size_t)(rowbase + qw0 - NMETA + (lane >> 4)) * D + h * 128 + (lane & 15) * 8;
#pragma unroll
            for (int i = 0; i < 8; ++i) { const u32x4 v = *(const LAS u32x4*)(stg + (i * 4 + (lane >> 4)) * 272 + (lane & 15) * 16); *(u32x4*)(op + (size_t)(i * 4) * D) = v; }
        }
    }
}

__device__ __forceinline__ void attn_phase(LAS unsigned char* lds, const bf16_t* U3, const bf16_t* VT, bf16_t* MIX, const float* tbl, const float* gain, float lam, unsigned* ctl) {
    volatile LAS int* misc = (volatile LAS int*)(lds + LDS_MISC);
    const int x0 = blockIdx.x & 7;
    for (int qi = 0; qi < 8; ++qi) {
        const int x = (x0 + qi) & 7;
        for (;;) {
            if (threadIdx.x == 0) misc[0] = (int)atomicAdd(ctl + x * 64, 1u);
            __syncthreads();
            const int idx = misc[0];
            __syncthreads();
            if (idx >= UNITS_PER_Q) break;
            int grp, b, h, qb;
            if (idx < 256) { const int i = idx >> 6; qb = idx & 63; const int p = x + 8 * i; grp = 1; b = p >> 2; h = p & 3; }
            else { const int j = idx - 256, i = j >> 4; qb = j & 15; const int p = x + 8 * i; grp = 0; b = p >> 2; h = p & 3; }
            attn_unit(lds, U3, VT, MIX, tbl, gain, lam, grp, b, h, qb);
        }
    }
}
}

__device__ __forceinline__ f32x4 meta_block(const bf16_t* __restrict__ A, int lda, const bf16_t* __restrict__ Bt, int K, int lane) {
    asm volatile("" : "+v"(lane));
    f32x4 acc = (f32x4){0.f, 0.f, 0.f, 0.f};
    const bf16_t* ap = A + (size_t)(lane & 15) * lda + (lane >> 4) * 8; const bf16_t* bp = Bt + (size_t)(lane & 15) * K + (lane >> 4) * 8;
#pragma unroll 8
    for (int k = 0; k < K; k += 32) acc = __builtin_amdgcn_mfma_f32_16x16x32_bf16(*(const bf16x8*)(ap + k), *(const bf16x8*)(bp + k), acc, 0, 0, 0);
    return acc;
}
__device__ __forceinline__ bf16_t bf16_of(float v) { return (bf16_t)(cvt_pk_bf16(v, 0.f) & 0xffffu); }
__device__ __forceinline__ void meta_gateup(const bf16_t* H, const bf16_t* WGU, bf16_t* HFF, const unsigned long long* ssq, int blk, int G, int lane) {
    asm volatile("" : "+v"(lane));
    for (int cb = blk; cb < FF / 16; cb += G) { const int grow = (cb >> 3) * 256 + (cb & 7) * 16;
        const f32x4 g = meta_block(H + (size_t)META0 * D, D, WGU + (size_t)grow * D, D, lane), u = meta_block(H + (size_t)META0 * D, D, WGU + (size_t)(grow + 128) * D, D, lane);
#pragma unroll
        for (int r = 0; r < 4; ++r) { const int row = META0 + 4 * (lane >> 4) + r; const float rs = rstd_of(ssq, row);
            HFF[(size_t)(row - META0) * FF + cb * 16 + (lane & 15)] = bf16_of(pg8::silu_mul(g[r] * rs, u[r] * rs)); } }
}
__device__ __forceinline__ void meta_down(const bf16_t* HFF, const bf16_t* WD, bf16_t* H, unsigned long long* ssq_out, int blk, int G, int lane) {
    asm volatile("" : "+v"(lane));
    for (int cb = blk; cb < D / 16; cb += G) {
        const f32x4 acc = meta_block(HFF, FF, WD + (size_t)cb * 16 * FF, FF, lane);
#pragma unroll
        for (int r = 0; r < 4; ++r) { const int row = META0 + 4 * (lane >> 4) + r; bf16_t* hp = H + (size_t)row * D + cb * 16 + (lane & 15);
            const float v = __uint_as_float((unsigned)*hp << 16) + acc[r]; *hp = bf16_of(v);
            float ss = v * v; ss += __shfl_xor(ss, 1); ss += __shfl_xor(ss, 2); ss += __shfl_xor(ss, 4); ss += __shfl_xor(ss, 8);
            if ((lane & 15) == 0) atomicAdd(ssq_out + row, (unsigned long long)(ss * SSQ_SCALE + 0.5f)); } }
}
__device__ __forceinline__ void meta_win(const bf16_t* H, const bf16_t* WIN, bf16_t* U3, bf16_t* VT, const unsigned long long* ssq, int blk, int G, int lane) {
    asm volatile("" : "+v"(lane));
    for (int cb = blk; cb < 2048 / 16; cb += G) {
        const f32x4 acc = meta_block(H + (size_t)META0 * D, D, WIN + (size_t)cb * 16 * D, D, lane);
#pragma unroll
        for (int r = 0; r < 4; ++r) { const int row = META0 + 4 * (lane >> 4) + r, col = cb * 16 + (lane & 15); const bf16_t v = bf16_of(acc[r] * rstd_of(ssq, row));
            if (col < 1536) U3[(size_t)row * 1536 + col] = v; else VT[(size_t)(col - 1536) * MPAD + row] = v; } }
}

__global__ void __launch_bounds__(512, 2) mk_fwd(Args a) {
    extern __shared__ __attribute__((aligned(16))) unsigned char lds_raw[];
    LAS unsigned char* lds = (LAS unsigned char*)lds_raw;
    cg::grid_group grid = cg::this_grid();
    const int tid = threadIdx.x, lane = tid & 63, wave = __builtin_amdgcn_readfirstlane(tid >> 6);
    const int G = gridDim.x, gw = blockIdx.x * 8 + wave, NGW = G * 8;
    unsigned char* ws = a.ws;
    bf16_t* H = (bf16_t*)(ws + WS_H); unsigned char* HFF = ws + WS_BIG; bf16_t* HFFM = (bf16_t*)(ws + WS_HFFM); bf16_t* U3 = (bf16_t*)(ws + WS_U3); bf16_t* VT = (bf16_t*)(ws + WS_VT); bf16_t* MIX = (bf16_t*)(ws + WS_MIX);
    unsigned long long* SSQ0 = (unsigned long long*)(ws + WS_SSQ); unsigned long long* SSQ1 = SSQ0 + 131072; unsigned long long* SSQ2 = SSQ0 + 2 * 131072; unsigned long long* SSQ3 = SSQ0 + 3 * 131072;
    const int lo = a.ph_lo, hi = a.ph_hi;
#define IN(k) (lo <= (k) && (k) < hi)
#define SEAM(k) do { if (IN(k) && IN((k) + 1)) grid.sync(); } while (0)

    if (IN(0)) prologue(a, lds, gw, NGW, lane, wave);
#ifdef PROBE_DUP_MISC
    if (IN(0)) { __syncthreads(); prologue(a, lds, gw, NGW, lane, wave); }
#endif
    SEAM(0);
#pragma unroll 1
    for (int pass = 0; pass < 2; ++pass) {
        const int pu = pass ? 6 : 1, pd = pass ? 7 : 2;
        if (IN(pu)) {
            if (pass == 0 && wave == 0) meta_gateup(H, (const bf16_t*)(ws + WS_WGU1), HFFM, SSQ0, (int)blockIdx.x, G, lane);
            pg8::Gemm g{(const bf16_t*)(ws + WS_H8), (const bf16_t*)(ws + (pass ? WS_WGU2_8 : WS_WGU1_8)), NREAL, 2 * FF, D / 2}; pg8::StaticOrder S; S.init(NREAL, 2 * FF, G, (int)blockIdx.x);
            pg8::EpiGateUp E{HFF, pass ? SSQ2 : SSQ0, 1.0f / W8_SCALE};
            pg8::gemm_phase<pg8::EpiGateUp, pg8::StaticOrder, true>(lds, g, S, E);
#ifdef PROBE_DUP_GU
            if (pass == 0) pg8::gemm_phase<pg8::EpiGateUp, pg8::StaticOrder>(lds, g, S, E);
#endif
        }
        SEAM(pu);
        if (IN(pd)) {
            if (pass == 0 && wave == 0) meta_down(HFFM, (const bf16_t*)(ws + WS_WD1), H, SSQ1, (int)blockIdx.x, G, lane);
            pg8::Gemm g{(const bf16_t*)HFF, (const bf16_t*)(ws + (pass ? WS_WD2_8 : WS_WD1_8)), NREAL, D, FF / 2}; pg8::StaticOrder S; S.init(NREAL, D, G, (int)blockIdx.x);
            pg8::EpiResid E{H, pass ? SSQ3 : SSQ1, nullptr, 1.0f / (HFF8_SCALE * WD8_SCALE)};
            pg8::gemm_phase<pg8::EpiResid, pg8::StaticOrder, true>(lds, g, S, E);
        }
        SEAM(pd);
        if (pass == 0) {
            if (IN(3)) {
                if (wave == 0) meta_win(H, (const bf16_t*)(ws + WS_WIN), U3, VT, SSQ1, (int)blockIdx.x, G, lane);
                { pg8::Gemm g{H, (const bf16_t*)(ws + WS_WIN), NREAL, 1536, D}; pg8::StaticOrder S; S.init(NREAL, 1536, G, (int)blockIdx.x);
                  pg8::EpiRowScale E{U3, 1536, SSQ1};
                  pg8::gemm_phase<pg8::EpiRowScale, pg8::StaticOrder>(lds, g, S, E); }
                { pg8::Gemm g{(const bf16_t*)(ws + WS_WIN) + (size_t)1536 * D, H, 512, NREAL, D}; pg8::StaticOrder S; S.init(512, NREAL, G, (int)blockIdx.x);
                  pg8::EpiColScale E{VT, MPAD, SSQ1};
                  pg8::gemm_phase<pg8::EpiColScale, pg8::StaticOrder>(lds, g, S, E); }
            }
            SEAM(3);
            if (IN(4)) {
                pool_phase(U3, MIX, gw, NGW, lane);
#ifdef PROBE_DUP_MISC
                pool_phase(U3, MIX, gw, NGW, lane);
#endif
                int ll = lane; asm volatile("" : "+v"(ll));
                const float s1 = wave_sum(a.in[10][ll] * a.in[11][ll]), s2 = wave_sum(a.in[12][ll] * a.in[13][ll]);
                const float lam = __expf(s1) - __expf(s2) + 0.2f;
                att::attn_phase(lds, U3, VT, MIX, a.in[3], a.in[14], lam, (unsigned*)(ws + WS_CTL));
#ifdef PROBE_DUP_ATT
                att::attn_phase(lds, U3, VT, MIX, a.in[3], a.in[14], lam, (unsigned*)(ws + WS_CTL) + 8 * 64);
#endif
            }
            SEAM(4);
            if (IN(5)) {
                pg8::Gemm g{MIX, (const bf16_t*)(ws + WS_WOUT), NREAL, D, D}; pg8::StaticOrder S; S.init(NREAL, D, G, (int)blockIdx.x);
                pg8::EpiResid E{H, SSQ2, ws + WS_H8, 1.0f};
                pg8::gemm_phase<pg8::EpiResid, pg8::StaticOrder>(lds, g, S, E);
            }
            SEAM(5);
        }
    }
    if (IN(8)) {
        const float* gf = a.in[22];
        for (int orow0 = gw * 4; orow0 < NOUT_ROWS; orow0 += NGW * 4) {
            u32x4 hv[4][2]; float rs[4];
#pragma unroll
            for (int i = 0; i < 4; ++i) { const int row = orow0 + i;
                rs[i] = rstd_of(SSQ3, row);
#pragma unroll
                for (int j = 0; j < 2; ++j) hv[i][j] = *(const u32x4*)(H + (size_t)row * D + (j * 64 + lane) * 8); }
#pragma unroll
            for (int j = 0; j < 2; ++j) { const int col = (j * 64 + lane) * 8; const f32x4 g0 = *(const f32x4*)(gf + col), g1 = *(const f32x4*)(gf + col + 4);
#pragma unroll
                for (int i = 0; i < 4; ++i) { const u32x4 h4 = hv[i][j]; const float r = rs[i];
                    f32x4 o0, o1; o0.x = bf_lo(h4.x) * r * g0.x; o0.y = bf_hi(h4.x) * r * g0.y; o0.z = bf_lo(h4.y) * r * g0.z; o0.w = bf_hi(h4.y) * r * g0.w;
                    o1.x = bf_lo(h4.z) * r * g1.x; o1.y = bf_hi(h4.z) * r * g1.y; o1.z = bf_lo(h4.w) * r * g1.z; o1.w = bf_hi(h4.w) * r * g1.w;
                    float* op = a.out + (size_t)(orow0 + i) * D + col; *(f32x4*)op = o0; *(f32x4*)(op + 4) = o1; } }
        }
    }
#undef IN
#undef SEAM
}

constexpr int LDS_BYTES = 147456;
extern "C" void kernel_launch(void* const* d_in, const int* in_sizes, int n_in, void* d_out, int out_size, void* d_ws, size_t ws_size, hipStream_t stream) {
    static int grid = 0;
    if (grid == 0) {
        if (n_in != 23 || out_size != NOUT_ROWS * D || ws_size < WS_END) { fprintf(stderr, "kernel_launch: unexpected shapes (n_in %d, out %d, ws %zu < %zu)\n", n_in, out_size, ws_size, (size_t)WS_END); grid = -1; return; }
        int dev = 0, cus = 0, per_cu = 0;
        (void)hipGetDevice(&dev); (void)hipDeviceGetAttribute(&cus, hipDeviceAttributeMultiprocessorCount, dev);
        (void)hipFuncSetAttribute((const void*)mk_fwd, hipFuncAttributeMaxDynamicSharedMemorySize, LDS_BYTES);
        if (hipOccupancyMaxActiveBlocksPerMultiprocessor(&per_cu, (const void*)mk_fwd, 512, LDS_BYTES) != hipSuccess || per_cu < 1) per_cu = 1;
        (void)hipGetLastError();
        grid = cus * 1;
        if (grid <= 0) grid = 256;
    }
    if (grid < 0) return;
    Args a{};
    for (int i = 0; i < 23; ++i) a.in[i] = (const float*)d_in[i];
    a.out = (float*)d_out; a.ws = (unsigned char*)d_ws;
#if MK_MULTI
    for (int p = 0; p < 9; ++p) { a.ph_lo = p; a.ph_hi = p + 1; hipLaunchKernelGGL(mk_fwd, dim3(grid), dim3(512), LDS_BYTES, stream, a); }
#else
    a.ph_lo = 0; a.ph_hi = 9;
    void* args[] = {&a};
    hipError_t e = hipLaunchCooperativeKernel((const void*)mk_fwd, dim3(grid), dim3(512), args, LDS_BYTES, stream);
    if (e != hipSuccess) fprintf(stderr, "cooperative launch failed: %s (grid %d)\n", hipGetErrorString(e), grid);
#endif
}
```

```cpp
#include <hip/hip_runtime.h>
#include <hip/hip_cooperative_groups.h>
#include <cstdio>
#include <cstdint>
namespace cg = cooperative_groups;

#ifndef MK_MULTI
#define MK_MULTI 0
#endif

#define LAS __attribute__((address_space(3)))
typedef unsigned short bf16_t;
typedef short bf16x8 __attribute__((ext_vector_type(8)));
typedef float f32x4 __attribute__((ext_vector_type(4)));
typedef float f32x16 __attribute__((ext_vector_type(16)));
typedef unsigned u32x4 __attribute__((ext_vector_type(4)));
typedef unsigned u32x2 __attribute__((ext_vector_type(2)));

constexpr int D = 1024, FF = 2816, NMETA = 16;
constexpr int NB1 = 16, S1 = 2048, NB2 = 8, S2 = 8192;
constexpr int L1 = S1 + NMETA, L2 = S2 + NMETA;
constexpr int M1 = NB1 * L1, M2 = NB2 * L2;
constexpr int MTOK = M1 + M2;
constexpr int MPAD = 98816;
constexpr int NOUT_ROWS = NB1 * S1 + NB2 * S2;
constexpr int NREAL = NOUT_ROWS, META0 = NREAL;
constexpr float EPS = 1e-6f;
constexpr float LOG2E = 1.4426950408889634f;
constexpr float C2 = 0.125f * LOG2E;
constexpr float SSQ_SCALE = 1048576.0f;

constexpr size_t MiB = 1u << 20;
constexpr size_t WS_CTL = 0;
constexpr size_t WS_BAR = 512 * 1024;
constexpr size_t WS_SSQ = 1 * MiB;
constexpr size_t WS_WGU1 = 8 * MiB, WS_WD1 = 20 * MiB, WS_WIN = 26 * MiB, WS_WOUT = 30 * MiB, WS_WGU2 = 32 * MiB, WS_WD2 = 44 * MiB;
constexpr size_t WS_H = 50 * MiB;
constexpr size_t WS_BIG = 243 * MiB;
constexpr size_t WS_U3 = WS_BIG;
constexpr size_t WS_VT = WS_BIG + (size_t)MPAD * 1536 * 2;
constexpr size_t WS_MIX = WS_VT + (size_t)512 * MPAD * 2;
constexpr size_t WS_H8 = WS_MIX + (size_t)MPAD * 1024 * 2;
constexpr size_t WS_WGU1_8 = WS_H8 + (size_t)MPAD * 1024, WS_WGU2_8 = WS_WGU1_8 + (size_t)2 * FF * D;
constexpr size_t WS_WD1_8 = WS_WGU2_8 + (size_t)2 * FF * D, WS_WD2_8 = WS_WD1_8 + (size_t)D * FF;
constexpr size_t WS_END = WS_WD2_8 + (size_t)D * FF;
constexpr size_t WS_HFFM = 128 * 1024;
constexpr float W8_SCALE = 64.0f, HFF8_SCALE = 8.0f, WD8_SCALE = 128.0f;
static_assert(WS_H + (size_t)MPAD * 2048 <= WS_BIG && WS_BIG + (size_t)MPAD * FF * 2 <= WS_H8, "ws map");
static_assert(WS_END <= 1024 * MiB, "ws map exceeds 1 GiB");

__device__ __forceinline__ unsigned cvt_pk_bf16(float lo, float hi) { unsigned r; asm volatile("v_cvt_pk_bf16_f32 %0, %1, %2" : "=v"(r) : "v"(lo), "v"(hi)); return r; }
typedef int i32x4 __attribute__((ext_vector_type(4)));
typedef int i32x8 __attribute__((ext_vector_type(8)));
__device__ __forceinline__ float clamp8(float v) { return __builtin_fminf(__builtin_fmaxf(v, -448.0f), 448.0f); }
__device__ __forceinline__ unsigned pk4_fp8(float a, float b, float c, float d) { int w = 0; w = __builtin_amdgcn_cvt_pk_fp8_f32(clamp8(a), clamp8(b), w, false); w = __builtin_amdgcn_cvt_pk_fp8_f32(clamp8(c), clamp8(d), w, true); return (unsigned)w; }
__device__ __forceinline__ float bf_lo(unsigned u) { return __uint_as_float(u << 16); }
__device__ __forceinline__ float bf_hi(unsigned u) { return __uint_as_float(u & 0xffff0000u); }
__device__ __forceinline__ float rstd_of(const unsigned long long* ssq, int row) { return rsqrtf((float)ssq[row] * (1.0f / (SSQ_SCALE * 1024.0f)) + EPS); }
__device__ __forceinline__ float wave_sum(float v) {
#pragma unroll
    for (int o = 1; o < 64; o <<= 1) v += __shfl_xor(v, o);
    return v;
}

namespace pg8 {
constexpr int BM = 256, BK = 64, HALF = 128, HTB = HALF * BK * 2, STAGE_BYTES = 8 * HTB, NXCD = 8, WGM = 8;
__host__ __device__ __forceinline__ int lds_byte(int r, int c) { const int st = (r >> 4) * 2 + (c >> 5), rr = r & 15, cc = c & 31, ob = rr * 64 + cc * 2; return st * 1024 + (ob ^ (((ob >> 9) & 1) << 5)); }
__host__ __device__ __forceinline__ void stage_rc(int b, int& R, int& C) { const int st = b / 1024, sb = b % 1024, swz = sb ^ (((sb >> 9) & 1) << 5); R = (st >> 1) * 16 + swz / 64; C = (st & 1) * 32 + (swz % 64) / 2; }
__host__ __device__ __forceinline__ int perm32(int rho) { const int n = rho >> 4, i = rho & 15; return 8 * (i >> 2) + 4 * n + (i & 3); }

struct Unit { int pm, pn; };
template <bool F8> struct FragSel { typedef bf16x8 type; };
template <> struct FragSel<true> { typedef i32x8 type; };
struct Gemm { const bf16_t* A; const bf16_t* Bt; int M, N, K; };

struct StaticOrder {
    int nM, nN, nwg, G, c;
    __host__ __device__ void init(int M, int N, int G_, int c_) { nM = M / BM; nN = N / BM; nwg = nM * nN; G = G_; c = c_; }
    __host__ __device__ bool next(int i, Unit& u) const {
        const long L = (long)i * G + c; if (L >= nwg) return false;
        int wgid = (int)L; { const int q = nwg / NXCD, r = nwg % NXCD, xcd = wgid % NXCD, off = wgid / NXCD; wgid = (xcd < r ? xcd * (q + 1) : r * (q + 1) + (xcd - r) * q) + off; }
        const int nig = WGM * nN, gid = wgid / nig, fm = gid * WGM, gsz = (nM - fm) < WGM ? (nM - fm) : WGM;
        u.pm = fm + ((wgid % nig) % gsz); u.pn = (wgid % nig) / gsz; return true;
    }
};

template <class Epi, class Sched, bool F8 = false>
__device__ __forceinline__ void gemm_phase(LAS unsigned char* lds, const Gemm g, const Sched& S, const Epi& E) {
    int tid = threadIdx.x; asm volatile("" : "+v"(tid));
    const int wid = __builtin_amdgcn_readfirstlane(tid >> 6), lane = tid & 63, wr = wid >> 2, wc = wid & 3, fr = lane & 15, fq = lane >> 4;
    using FragT = typename FragSel<F8>::type; constexpr int NKF = F8 ? 1 : 2;
    unsigned sc1 = 0x7F7F7F7Fu; asm volatile("" : "+v"(sc1));
    const int K = g.K, nt = K / BK;
    unsigned voffA[2], voffB[2];
#pragma unroll
    for (int i = 0; i < 2; ++i) { int R, C; stage_rc(tid * 16 + i * 8192, R, C); const int Rb = (R & ~31) + perm32(R & 31);
        voffA[i] = (unsigned)(R * K + C) * 2u; voffB[i] = (unsigned)(Rb * K + C) * 2u; }
    asm volatile("" : "+v"(voffA[0]), "+v"(voffA[1]), "+v"(voffB[0]), "+v"(voffB[1]));
    const size_t kstep = (size_t)(BK * 2);
    const size_t hstep = (size_t)HALF * K * 2;
    const size_t tstep = 2 * hstep;
    const unsigned ldsw = (unsigned)wid * 1024u;
    const int aoff = lds_byte(wr * 64 + fr, fq * 8), boff = lds_byte(wc * 32 + fr, fq * 8);
#define PG8_SA(b, h) (((b) * 2 + (h)) * HTB)
#define PG8_SB(b, h) ((4 + (b) * 2 + (h)) * HTB)
#define PG8_STAGE(bufoff, gbase, voff) do { _Pragma("unroll") for (int _i = 0; _i < 2; ++_i) \
        __builtin_amdgcn_global_load_lds((const unsigned*)((const char*)(gbase) + (voff)[_i]), (LAS unsigned*)(lds + (bufoff) + ldsw + _i * 8192), 16, 0, 0); } while (0)
#define PG8_LD1(dst, addr) do { if constexpr (F8) { dst[0] = __builtin_shufflevector(*(const LAS i32x4*)(addr), *(const LAS i32x4*)((addr) + 1024), 0, 1, 2, 3, 4, 5, 6, 7); } \
        else { _Pragma("unroll") for (int k = 0; k < NKF; ++k) dst[k] = *(const LAS FragT*)((addr) + k * 1024); } } while (0)
#define PG8_LDA(dst, b, h) do { _Pragma("unroll") for (int m = 0; m < 4; ++m) PG8_LD1(dst[m], lds + PG8_SA(b, h) + aoff + m * 2048); } while (0)
#define PG8_LDB(dst, b, h) do { _Pragma("unroll") for (int n = 0; n < 2; ++n) PG8_LD1(dst[n], lds + PG8_SB(b, h) + boff + n * 2048); } while (0)
#define PG8_MMA(ai, bj, At, Bt) do { __builtin_amdgcn_s_setprio(1); _Pragma("unroll") for (int m = 0; m < 4; ++m) _Pragma("unroll") for (int n = 0; n < 2; ++n) { \
        if constexpr (F8) { asm volatile("v_mfma_scale_f32_16x16x128_f8f6f4 %0, %1, %2, %0, %3, %3 op_sel_hi:[0,0,0]" : "+v"(acc[ai][bj][m][n]) : "v"(Bt[n][0]), "v"(At[m][0]), "v"(sc1)); } \
        else { _Pragma("unroll") for (int k = 0; k < 2; ++k) acc[ai][bj][m][n] = __builtin_amdgcn_mfma_f32_16x16x32_bf16(Bt[n][k], At[m][k], acc[ai][bj][m][n], 0, 0, 0); } } \
        __builtin_amdgcn_s_setprio(0); } while (0)
#define PG8_WAIT_V(n) asm volatile("s_waitcnt vmcnt(" #n ")" ::: "memory")
#define PG8_WAIT_L(n) asm volatile("s_waitcnt lgkmcnt(" #n ")" ::: "memory")
#define PG8_BAR __builtin_amdgcn_s_barrier()
#define PG8_SCHED __builtin_amdgcn_sched_barrier(0)
    Unit cur, nxt; int ui = 0;
    if (!S.next(0, cur)) return;
    f32x4 acc[2][2][4][2];
#pragma unroll
    for (int a = 0; a < 2; ++a)
#pragma unroll
        for (int b = 0; b < 2; ++b)
#pragma unroll
            for (int m = 0; m < 4; ++m)
#pragma unroll
                for (int n = 0; n < 2; ++n) acc[a][b][m][n] = (f32x4){0.f, 0.f, 0.f, 0.f};
    FragT At[4][NKF], B0[2][NKF], B1[2][NKF];
    unsigned long long pfv[8];
    const char* cA = (const char*)g.A + (size_t)cur.pm * tstep; const char* cB = (const char*)g.Bt + (size_t)cur.pn * tstep;
    PG8_STAGE(PG8_SB(0, 0), cB, voffB); PG8_STAGE(PG8_SB(0, 1), cB + hstep, voffB); PG8_STAGE(PG8_SA(0, 0), cA, voffA); PG8_STAGE(PG8_SA(0, 1), cA + hstep, voffA);
    if (wr == 1) PG8_BAR;
    PG8_WAIT_V(2); PG8_BAR;
    PG8_STAGE(PG8_SB(1, 0), cB + kstep, voffB); PG8_STAGE(PG8_SA(1, 0), cA + kstep, voffA); PG8_STAGE(PG8_SB(1, 1), cB + hstep + kstep, voffB);
    PG8_WAIT_V(6); PG8_BAR;
    for (;;) {
        const bool has_next = S.next(ui + 1, nxt);
        const char* nA = has_next ? (const char*)g.A + (size_t)nxt.pm * tstep : cA; const char* nB = has_next ? (const char*)g.Bt + (size_t)nxt.pn * tstep : cB;
#pragma unroll 1
        for (int t = 0; t < nt; t += 2) {
            const bool last = (t == nt - 2);
            if constexpr (Epi::PREF) { if (last) E.prefetch(pfv, cur, wr, fr); }
            const char* a1 = cA + (size_t)(t + 1) * kstep;
            const char* a2 = last ? nA : cA + (size_t)(t + 2) * kstep; const char* b2 = last ? nB : cB + (size_t)(t + 2) * kstep;
            const char* a3 = a2 + kstep; const char* b3 = b2 + kstep;
            PG8_LDB(B0, 0, 0); PG8_LDB(B1, 0, 1); PG8_SCHED; PG8_LDA(At, 0, 0); PG8_STAGE(PG8_SA(1, 1), a1 + hstep, voffA);
            PG8_WAIT_V(8); PG8_WAIT_L(0); PG8_BAR; PG8_MMA(0, 0, At, B0); PG8_MMA(0, 1, At, B1); PG8_BAR; PG8_SCHED;
            PG8_LDA(At, 0, 1); PG8_STAGE(PG8_SB(0, 0), b2, voffB); PG8_STAGE(PG8_SB(0, 1), b2 + hstep, voffB); PG8_STAGE(PG8_SA(0, 0), a2, voffA);
            PG8_WAIT_V(8); PG8_WAIT_L(0); PG8_BAR; PG8_MMA(1, 0, At, B0); PG8_MMA(1, 1, At, B1); PG8_BAR; PG8_SCHED;
            PG8_LDB(B0, 1, 0); PG8_LDB(B1, 1, 1); PG8_SCHED; PG8_LDA(At, 1, 0); PG8_STAGE(PG8_SA(0, 1), a2 + hstep, voffA);
            PG8_WAIT_V(8); PG8_WAIT_L(0); PG8_BAR; PG8_MMA(0, 0, At, B0); PG8_MMA(0, 1, At, B1); PG8_BAR; PG8_SCHED;
            PG8_LDA(At, 1, 1); PG8_STAGE(PG8_SB(1, 0), b3, voffB); PG8_STAGE(PG8_SB(1, 1), b3 + hstep, voffB); PG8_STAGE(PG8_SA(1, 0), a3, voffA);
            PG8_WAIT_V(8); PG8_WAIT_L(0); PG8_BAR; PG8_MMA(1, 0, At, B0); PG8_MMA(1, 1, At, B1); PG8_BAR; PG8_SCHED;
        }
        if (wr == 0) PG8_BAR;
        if constexpr (F8) { asm volatile("s_nop 15\n\ts_nop 7" ::: "memory"); PG8_SCHED; }
        if constexpr (Epi::PREF) E(acc, cur, wr, wc, fr, fq, pfv); else E(acc, cur, wr, wc, fr, fq);
        if (!has_next) break;
#pragma unroll
        for (int a = 0; a < 2; ++a)
#pragma unroll
            for (int b = 0; b < 2; ++b)
#pragma unroll
                for (int m = 0; m < 4; ++m)
#pragma unroll
                    for (int n = 0; n < 2; ++n) acc[a][b][m][n] = (f32x4){0.f, 0.f, 0.f, 0.f};
        cur = nxt; cA = nA; cB = nB; ++ui;
        if (wr == 1) PG8_BAR;
    }
    PG8_WAIT_V(0);
    PG8_BAR;
#undef PG8_SA
#undef PG8_SB
#undef PG8_STAGE
#undef PG8_LDA
#undef PG8_LD1
#undef PG8_LDB
#undef PG8_MMA
#undef PG8_WAIT_V
#undef PG8_WAIT_L
#undef PG8_BAR
#undef PG8_SCHED
}

__device__ __forceinline__ float silu_mul(float g, float u) { return g * __builtin_amdgcn_rcpf(1.0f + __builtin_amdgcn_exp2f(-g * LOG2E)) * u; }
struct EpiGateUp {
    static constexpr bool PREF = true;
    unsigned char* O; const unsigned long long* ssq; float wsc;
    __device__ __forceinline__ void prefetch(unsigned long long (&pf)[8], const Unit& u, int wr, int fr) const {
        const int row0 = u.pm * BM + wr * 64 + fr;
#pragma unroll
        for (int ai = 0; ai < 2; ++ai)
#pragma unroll
            for (int m = 0; m < 4; ++m) pf[ai * 4 + m] = ssq[row0 + ai * HALF + m * 16];
    }
    __device__ __forceinline__ void operator()(const f32x4 (&acc)[2][2][4][2], const Unit& u, int wr, int wc, int fr, int fq, const unsigned long long (&pf)[8]) const {
        const int row0 = u.pm * BM + wr * 64 + fr, col0 = u.pn * HALF + wc * 32 + 8 * fq;
#pragma unroll
        for (int ai = 0; ai < 2; ++ai)
#pragma unroll
            for (int m = 0; m < 4; ++m) { const int row = row0 + ai * HALF + m * 16; const float rs = rsqrtf((float)pf[ai * 4 + m] * (1.0f / (SSQ_SCALE * 1024.0f)) + EPS) * wsc;
                const f32x4 g0 = acc[ai][0][m][0] * rs, g1 = acc[ai][0][m][1] * rs, u0 = acc[ai][1][m][0] * rs, u1 = acc[ai][1][m][1] * rs;
                u32x2 w; w.x = pk4_fp8(silu_mul(g0[0], u0[0]) * HFF8_SCALE, silu_mul(g0[1], u0[1]) * HFF8_SCALE, silu_mul(g0[2], u0[2]) * HFF8_SCALE, silu_mul(g0[3], u0[3]) * HFF8_SCALE);
                w.y = pk4_fp8(silu_mul(g1[0], u1[0]) * HFF8_SCALE, silu_mul(g1[1], u1[1]) * HFF8_SCALE, silu_mul(g1[2], u1[2]) * HFF8_SCALE, silu_mul(g1[3], u1[3]) * HFF8_SCALE);
                *(u32x2*)(O + (size_t)row * FF + col0) = w; }
    }
};
struct EpiResid {
    static constexpr bool PREF = false;
    bf16_t* H; unsigned long long* ssq_out; unsigned char* H8; float asc;
    __device__ __forceinline__ void operator()(const f32x4 (&acc)[2][2][4][2], const Unit& u, int wr, int wc, int fr, int fq) const {
        const int row0 = u.pm * BM + wr * 64 + fr, col0 = u.pn * BM + wc * 32 + 8 * fq;
#pragma unroll
        for (int ai = 0; ai < 2; ++ai)
#pragma unroll
            for (int m = 0; m < 4; ++m) { const int row = row0 + ai * HALF + m * 16; float ss = 0.f;
#pragma unroll
                for (int bj = 0; bj < 2; ++bj) { bf16_t* p = H + (size_t)row * D + col0 + bj * HALF; const u32x4 hv = *(const u32x4*)p;
                    const f32x4 a0 = acc[ai][bj][m][0] * asc, a1 = acc[ai][bj][m][1] * asc;
                    const float v0 = bf_lo(hv.x) + a0[0], v1 = bf_hi(hv.x) + a0[1], v2 = bf_lo(hv.y) + a0[2], v3 = bf_hi(hv.y) + a0[3];
                    const float v4 = bf_lo(hv.z) + a1[0], v5 = bf_hi(hv.z) + a1[1], v6 = bf_lo(hv.w) + a1[2], v7 = bf_hi(hv.w) + a1[3];
                    ss += (v0 * v0 + v1 * v1) + (v2 * v2 + v3 * v3) + (v4 * v4 + v5 * v5) + (v6 * v6 + v7 * v7);
                    u32x4 w; w.x = cvt_pk_bf16(v0, v1); w.y = cvt_pk_bf16(v2, v3); w.z = cvt_pk_bf16(v4, v5); w.w = cvt_pk_bf16(v6, v7);
                    *(u32x4*)p = w;
                    if (H8) { u32x2 w8; w8.x = pk4_fp8(v0, v1, v2, v3); w8.y = pk4_fp8(v4, v5, v6, v7); *(u32x2*)(H8 + (size_t)row * D + col0 + bj * HALF) = w8; } }
                ss += __shfl_xor(ss, 16); ss += __shfl_xor(ss, 32);
                if (fq == 0) atomicAdd(ssq_out + row, (unsigned long long)(ss * SSQ_SCALE + 0.5f)); }
    }
};
struct EpiRowScale {
    static constexpr bool PREF = false;
    bf16_t* O; int ldc; const unsigned long long* ssq;
    __device__ __forceinline__ void operator()(const f32x4 (&acc)[2][2][4][2], const Unit& u, int wr, int wc, int fr, int fq) const {
        const int row0 = u.pm * BM + wr * 64 + fr, col0 = u.pn * BM + wc * 32 + 8 * fq;
#pragma unroll
        for (int ai = 0; ai < 2; ++ai)
#pragma unroll
            for (int m = 0; m < 4; ++m) { const int row = row0 + ai * HALF + m * 16; const float rs = rstd_of(ssq, row);
#pragma unroll
                for (int bj = 0; bj < 2; ++bj) { const f32x4 v0 = acc[ai][bj][m][0] * rs, v1 = acc[ai][bj][m][1] * rs;
                    u32x4 w; w.x = cvt_pk_bf16(v0[0], v0[1]); w.y = cvt_pk_bf16(v0[2], v0[3]); w.z = cvt_pk_bf16(v1[0], v1[1]); w.w = cvt_pk_bf16(v1[2], v1[3]);
                    *(u32x4*)(O + (size_t)row * ldc + col0 + bj * HALF) = w; } }
    }
};
struct EpiColScale {
    static constexpr bool PREF = false;
    bf16_t* O; int ldc; const unsigned long long* ssq;
    __device__ __forceinline__ void operator()(const f32x4 (&acc)[2][2][4][2], const Unit& u, int wr, int wc, int fr, int fq) const {
        const int row0 = u.pm * BM + wr * 64 + fr, col0 = u.pn * BM + wc * 32 + 8 * fq;
#pragma unroll
        for (int bj = 0; bj < 2; ++bj) {
            float rs[8];
#pragma unroll
            for (int j = 0; j < 8; ++j) rs[j] = rstd_of(ssq, col0 + bj * HALF + j);
#pragma unroll
            for (int ai = 0; ai < 2; ++ai)
#pragma unroll
                for (int m = 0; m < 4; ++m) { const int row = row0 + ai * HALF + m * 16; const f32x4 v0 = acc[ai][bj][m][0], v1 = acc[ai][bj][m][1];
                    u32x4 w; w.x = cvt_pk_bf16(v0[0] * rs[0], v0[1] * rs[1]); w.y = cvt_pk_bf16(v0[2] * rs[2], v0[3] * rs[3]);
                    w.z = cvt_pk_bf16(v1[0] * rs[4], v1[1] * rs[5]); w.w = cvt_pk_bf16(v1[2] * rs[6], v1[3] * rs[7]);
                    *(u32x4*)(O + (size_t)row * ldc + col0 + bj * HALF) = w; }
        }
    }
};
}

template <int MODE>
__device__ __forceinline__ void tr2_item(const float* __restrict__ W, int ldw, int k0, int n0, bf16_t* __restrict__ WT, unsigned char* __restrict__ WT8, int ldt, int dst_row0, int dst_k0,
                                         const float* __restrict__ ks, float cs, float cs8, LAS float* scr, int lane) {
    f32x4 v[16];
#pragma unroll
    for (int i = 0; i < 16; ++i) { const int r = 2 * i + (lane >> 5); v[i] = *(const f32x4*)(W + (size_t)(k0 + r) * ldw + n0 + (lane & 31) * 4); }
#pragma unroll
    for (int i = 0; i < 16; ++i) { const int r = 2 * i + (lane >> 5); const float sc = ks ? ks[k0 + r] : 1.0f; LAS float* d = scr + r * 129 + (lane & 31) * 4;
        d[0] = v[i].x * sc; d[1] = v[i].y * sc; d[2] = v[i].z * sc; d[3] = v[i].w * sc; }
    asm volatile("s_waitcnt lgkmcnt(0)" ::: "memory");
    if constexpr (MODE != 0) { const int c = lane & 1;
#pragma unroll
        for (int j = 0; j < 4; ++j) { const int n = (lane >> 1) + 32 * j; const LAS float* s = scr + (16 * c) * 129 + n;
            u32x4 o; o.x = pk4_fp8(s[0 * 129] * cs8, s[1 * 129] * cs8, s[2 * 129] * cs8, s[3 * 129] * cs8); o.y = pk4_fp8(s[4 * 129] * cs8, s[5 * 129] * cs8, s[6 * 129] * cs8, s[7 * 129] * cs8);
            o.z = pk4_fp8(s[8 * 129] * cs8, s[9 * 129] * cs8, s[10 * 129] * cs8, s[11 * 129] * cs8); o.w = pk4_fp8(s[12 * 129] * cs8, s[13 * 129] * cs8, s[14 * 129] * cs8, s[15 * 129] * cs8);
            *(u32x4*)(WT8 + (size_t)(dst_row0 + n) * ldt + dst_k0 + k0 + 16 * c) = o; }
    }
    if constexpr (MODE != 1) { const int c = lane & 3;
#pragma unroll
        for (int j = 0; j < 8; ++j) { const int n = (lane >> 2) + 16 * j; const LAS float* s = scr + (8 * c) * 129 + n;
            u32x4 o; o.x = cvt_pk_bf16(s[0 * 129] * cs, s[1 * 129] * cs); o.y = cvt_pk_bf16(s[2 * 129] * cs, s[3 * 129] * cs); o.z = cvt_pk_bf16(s[4 * 129] * cs, s[5 * 129] * cs); o.w = cvt_pk_bf16(s[6 * 129] * cs, s[7 * 129] * cs);
            *(u32x4*)(WT + (size_t)(dst_row0 + n) * ldt + dst_k0 + k0 + 8 * c) = o; }
    }
    asm volatile("s_waitcnt lgkmcnt(0)" ::: "memory");
}

struct Args { const float* in[23]; float* out; unsigned char* ws; int ph_lo, ph_hi; };

__device__ __forceinline__ void prologue(const Args& a, LAS unsigned char* lds, int gw, int NGW, int lane, int wave) {
    asm volatile("" : "+v"(lane));
    unsigned char* ws = a.ws;
    LAS float* scr = (LAS float*)(lds + wave * 16512);
    bf16_t* WGU1 = (bf16_t*)(ws + WS_WGU1); bf16_t* WD1 = (bf16_t*)(ws + WS_WD1); bf16_t* WIN = (bf16_t*)(ws + WS_WIN); bf16_t* WOUT = (bf16_t*)(ws + WS_WOUT);
    constexpr int I_GU = (D / 32) * (FF / 128), I_DN = (FF / 32) * (D / 128), I_IN = (D / 32) * (2048 / 128), I_OUT = (512 / 32) * (D / 128);
    constexpr int NITEMS = 6 * I_GU + I_IN + I_OUT;
    static_assert(I_GU == I_DN, "item counts");
#ifdef PROBE_DUP_W
    for (int rep_ = 0; rep_ < 2; ++rep_)
#endif
    for (int it = gw; it < NITEMS; it += NGW) {
        int r = it;
        if (r < 6 * I_GU) {
            const int which = r / I_GU; r -= which * I_GU; const int layer = which / 3, kind = which % 3;
            if (kind < 2) { const int nblk = FF / 128, kb = r / nblk, nb = r % nblk, n0 = nb * 128; const int drow = nb * 256 + kind * 128;
                if (layer) tr2_item<1>(a.in[19 + kind], FF, kb * 32, n0, nullptr, ws + WS_WGU2_8, D, drow, 0, a.in[18], 1.0f, W8_SCALE, scr, lane);
                else tr2_item<2>(a.in[5 + kind], FF, kb * 32, n0, WGU1, ws + WS_WGU1_8, D, drow, 0, a.in[4], 1.0f, W8_SCALE, scr, lane);
            } else { const int nblk = D / 128, kb = r / nblk, nb = r % nblk, n0 = nb * 128;
                if (layer) tr2_item<1>(a.in[21], D, kb * 32, n0, nullptr, ws + WS_WD2_8, FF, n0, 0, nullptr, 0.5f, 0.5f * WD8_SCALE, scr, lane);
                else tr2_item<2>(a.in[7], D, kb * 32, n0, WD1, ws + WS_WD1_8, FF, n0, 0, nullptr, 0.5f, 0.5f * WD8_SCALE, scr, lane); }
            continue;
        }
        r -= 6 * I_GU;
        if (r < I_IN) { const int nblk = 2048 / 128, kb = r / nblk, nb = r % nblk, n0 = nb * 128;
            const int drow = n0 < 1024 ? n0 : (n0 < 1536 ? n0 + 512 : n0 - 512);
            tr2_item<0>(a.in[9], 2048, kb * 32, n0, WIN, nullptr, D, drow, 0, a.in[8], n0 < 512 ? C2 : 1.0f, 0.f, scr, lane); continue; }
        r -= I_IN;
        { const int nblk = D / 128, kb = r / nblk, nb = r % nblk, n0 = nb * 128;
          tr2_item<0>(a.in[17], D, kb * 32, n0, WOUT, nullptr, D, n0, 0, nullptr, 1.0f, 0.f, scr, lane); }
    }
    for (int it = gw; it < 2048; it += NGW) {
        const int g = it >> 9, nb = (it >> 5) & 15, cb = it & 31, n = nb * 64 + lane;
        const float* pw = a.in[15] + (size_t)(g * 128 + cb * 4) * 128; const float* ps = a.in[16] + g * 128; const float* wo = a.in[17] + (size_t)(512 + g * 128) * D + n;
        float acc[4] = {0.f, 0.f, 0.f, 0.f};
#pragma unroll 32
        for (int d = 0; d < 128; ++d) { const float w = wo[(size_t)d * D] * ps[d];
#pragma unroll
            for (int c = 0; c < 4; ++c) acc[c] += pw[c * 128 + d] * w; }
        u32x2 o0; o0.x = cvt_pk_bf16(acc[0], acc[1]); o0.y = cvt_pk_bf16(acc[2], acc[3]);
        *(u32x2*)(WOUT + (size_t)n * D + 512 + g * 128 + cb * 4) = o0;
    }
    bf16_t* H = (bf16_t*)(ws + WS_H); unsigned long long* SSQ = (unsigned long long*)(ws + WS_SSQ);
    for (int row0 = gw * 4; row0 < MPAD; row0 += NGW * 4) {
        f32x4 v[4][4];
#pragma unroll
        for (int i = 0; i < 4; ++i) { const int row = row0 + i;
            if (row < NREAL + NMETA) { const float* src = row < NB1 * S1 ? a.in[0] + (size_t)row * D : (row < NREAL ? a.in[1] + (size_t)(row - NB1 * S1) * D : a.in[2] + (size_t)(row - NREAL) * D);
#pragma unroll
                for (int j = 0; j < 4; ++j) v[i][j] = ((const f32x4*)src)[lane + 64 * j];
            } else {
#pragma unroll
                for (int j = 0; j < 4; ++j) v[i][j] = (f32x4){0.f, 0.f, 0.f, 0.f};
            } }
#pragma unroll
        for (int i = 0; i < 4; ++i) { const int row = row0 + i; float s = 0.f;
#pragma unroll
            for (int j = 0; j < 4; ++j) s += (v[i][j].x * v[i][j].x + v[i][j].y * v[i][j].y) + (v[i][j].z * v[i][j].z + v[i][j].w * v[i][j].w);
            s = wave_sum(s);
            u32x2* o8 = (u32x2*)(H + (size_t)row * D) + lane;
#pragma unroll
            for (int j = 0; j < 4; ++j) { u32x2 w; w.x = cvt_pk_bf16(v[i][j].x, v[i][j].y); w.y = cvt_pk_bf16(v[i][j].z, v[i][j].w); o8[64 * j] = w;
                ((unsigned*)(ws + WS_H8 + (size_t)row * D))[lane + 64 * j] = pk4_fp8(v[i][j].x, v[i][j].y, v[i][j].z, v[i][j].w); }
            if (lane == 0) { SSQ[row] = (unsigned long long)(s * SSQ_SCALE + 0.5f); SSQ[131072 + row] = 0ull; SSQ[2 * 131072 + row] = 0ull; SSQ[3 * 131072 + row] = 0ull; } }
    }
    if (gw == 0 && lane < 16) ((unsigned*)(ws + WS_CTL))[lane * 64] = 0u;
    if (blockIdx.x == 0) { for (int i = threadIdx.x; i < 257; i += 512) ((unsigned*)(ws + WS_BAR))[64 * i] = 0u; }
    {
        static_assert((size_t)NREAL * FF <= (size_t)(META0 + NMETA) * 1536 * 2, "hff (fp8, real rows only) must end below the zeroed U3 rows");
        bf16_t* U3z = (bf16_t*)(ws + WS_U3) + (size_t)(META0 + NMETA) * 1536; bf16_t* VTz = (bf16_t*)(ws + WS_VT) + META0 + NMETA;
        const u32x4 z4 = (u32x4){0u, 0u, 0u, 0u};
        for (int i = gw * 64 + lane; i < 48 * 1536 / 8; i += NGW * 64) *(u32x4*)(U3z + (size_t)i * 8) = z4;
        for (int i = gw * 64 + lane; i < 512 * 6; i += NGW * 64) *(u32x4*)(VTz + (size_t)(i / 6) * MPAD + (i % 6) * 8) = z4;
    }
}

__device__ __forceinline__ void pool_acc(float (&sum)[8], const u32x4 x, float sgn) {
    sum[0] += sgn * bf_lo(x.x); sum[1] += sgn * bf_hi(x.x); sum[2] += sgn * bf_lo(x.y); sum[3] += sgn * bf_hi(x.y);
    sum[4] += sgn * bf_lo(x.z); sum[5] += sgn * bf_hi(x.z); sum[6] += sgn * bf_lo(x.w); sum[7] += sgn * bf_hi(x.w); }
__device__ __forceinline__ void pool_phase(const bf16_t* __restrict__ U3, bf16_t* __restrict__ MIX, int gw, int NGW, int lane) {
    asm volatile("" : "+v"(lane));
    constexpr int NTASK = NREAL / 8;
    const int g = lane >> 4, w2 = 1 << g, col = lane * 8;
    const u32x4 z4 = (u32x4){0u, 0u, 0u, 0u};
    const bf16_t* xcol = U3 + 1024 + col;
    for (int task = gw; task < NTASK; task += NGW) {
        const int r0 = task * 8; int seqbase, L;
        if (r0 < NB1 * S1) { seqbase = r0 & ~(S1 - 1); L = L1; } else { seqbase = NB1 * S1 + ((r0 - NB1 * S1) & ~(S2 - 1)); L = L2; }
        const int t0 = r0 - seqbase + NMETA;
#define XROW(tt) (xcol + (size_t)((tt) < NMETA ? META0 + (tt) : seqbase + (tt) - NMETA) * 1536)
        u32x4 wv[16];
#pragma unroll
        for (int j = 0; j < 16; ++j) { const int tt = t0 - 8 + j; wv[j] = (j >= 8 - w2 && j < 8 + w2 && tt >= 0 && tt < L) ? *(const u32x4*)XROW(tt) : z4; }
        float sum[8];
#pragma unroll
        for (int e = 0; e < 8; ++e) sum[e] = 0.f;
#pragma unroll
        for (int j = 0; j < 16; ++j) pool_acc(sum, wv[j], 1.0f);
        u32x4 xc[8], xa[8], xs[8];
#pragma unroll
        for (int i = 0; i < 8; ++i) { const int t = t0 + i; xc[i] = *(const u32x4*)XROW(t);
            xa[i] = (t + w2 < L) ? *(const u32x4*)XROW(t + w2) : z4; xs[i] = (t - w2 >= 0) ? *(const u32x4*)XROW(t - w2) : z4; }
#pragma unroll
        for (int i = 0; i < 8; ++i) { const int t = t0 + i; const int lo = max(t - w2, 0), hi = min(t + w2, L); const float inv = 1.0f / (float)(hi - lo);
            const u32x4 x = xc[i];
            u32x4 o; o.x = cvt_pk_bf16(sum[0] * inv - bf_lo(x.x), sum[1] * inv - bf_hi(x.x)); o.y = cvt_pk_bf16(sum[2] * inv - bf_lo(x.y), sum[3] * inv - bf_hi(x.y));
            o.z = cvt_pk_bf16(sum[4] * inv - bf_lo(x.z), sum[5] * inv - bf_hi(x.z)); o.w = cvt_pk_bf16(sum[6] * inv - bf_lo(x.w), sum[7] * inv - bf_hi(x.w));
            *(u32x4*)(MIX + (size_t)(r0 + i) * D + 512 + col) = o;
            pool_acc(sum, xa[i], 1.0f); pool_acc(sum, xs[i], -1.0f); }
    }
#undef XROW
}

namespace att {
constexpr int STAGE = 32768;
constexpr int LDS_COMB = 0;
constexpr int LDS_LUT = 131072;
constexpr int LDS_MISC = 131072 + 2048;
constexpr float NEG = -1.0e30f;
constexpr int UNITS_PER_Q = 4 * 64 + 8 * 16;

__device__ __forceinline__ unsigned cvtpk(float lo, float hi) { typedef float f2 __attribute__((ext_vector_type(2))); typedef __bf16 b2 __attribute__((ext_vector_type(2)));
    f2 v = {lo, hi}; b2 b = __builtin_convertvector(v, b2); return __builtin_bit_cast(unsigned, b); }

__device__ __forceinline__ void attn_unit(LAS unsigned char* lds, const bf16_t* __restrict__ U3, const bf16_t* __restrict__ VT, bf16_t* __restrict__ MIX,
                                          const float* __restrict__ tbl, const float* __restrict__ gain, float lam, int grp, int b, int h, int qb) {
    int tid = threadIdx.x; asm volatile("" : "+v"(tid));
    const int lane = tid & 63, r32 = lane & 31, hi = lane >> 5;
    const int w = __builtin_amdgcn_readfirstlane(tid >> 6), c = w >> 2;
    const int S = grp ? S2 : S1, rowbase = grp ? NB1 * S1 + b * S2 : b * S1, NT = (S >> 6) + 1;
    const int qw0 = NMETA + qb * 128 + (w & 3) * 32, q = qw0 + r32;
    LAS float* lut = (LAS float*)(lds + LDS_LUT);
    if (tid < 257) { const int rel = tid - 128, n = rel < 0 ? -rel : rel;
        int bk = n < 8 ? n : 8 + (n >= 12) + (n >= 16) + (n >= 23) + (n >= 32) + (n >= 46) + (n >= 64) + (n >= 91);
        if (rel > 0) bk += 16;
        lut[tid] = tbl[bk * 4 + h] * LOG2E; }
    bf16x8 qr[4];
    { const bf16_t* qp = U3 + (size_t)(rowbase + q - NMETA) * 1536 + h * 128 + c * 64 + hi * 8;
#pragma unroll
      for (int d0 = 0; d0 < 4; ++d0) qr[d0] = *(const bf16x8*)(qp + d0 * 16); }
    const bf16_t* kg[2]; const bf16_t* vg[2];
#pragma unroll
    for (int i = 0; i < 2; ++i) { const int row = 4 * (i * 8 + w) + (lane >> 4), kch = (lane & 15) ^ (row & 15);
        kg[i] = U3 + (size_t)row * 1536 + 512 + h * 128 + kch * 8;
        const int rp = row, p = (lane & 15) ^ (rp & 15), dv = 2 * rp + (p >> 3), ch = p & 7;
        vg[i] = VT + (size_t)(h * 128 + dv) * MPAD + ch * 8; }
#define ATT_DMA(T, SLOT) do { LAS unsigned char* sb_ = lds + (SLOT) * STAGE + w * 1024; const int tr_ = ((T) < NT - 1) ? rowbase + (T) * 64 : META0; \
        __builtin_amdgcn_global_load_lds((const unsigned*)(kg[0] + (size_t)tr_ * 1536), (LAS unsigned*)(sb_), 16, 0, 0); \
        __builtin_amdgcn_global_load_lds((const unsigned*)(kg[1] + (size_t)tr_ * 1536), (LAS unsigned*)(sb_ + 8192), 16, 0, 0); \
        __builtin_amdgcn_global_load_lds((const unsigned*)(vg[0] + tr_), (LAS unsigned*)(sb_ + 16384), 16, 0, 0); \
        __builtin_amdgcn_global_load_lds((const unsigned*)(vg[1] + tr_), (LAS unsigned*)(sb_ + 24576), 16, 0, 0); } while (0)
    const int pi = (r32 & 0x13) | ((r32 & 4) << 1) | ((r32 & 8) >> 1);
    unsigned koff[4], voff[4];
#pragma unroll
    for (int d0 = 0; d0 < 4; ++d0) koff[d0] = pi * 256 + (((c * 8 + d0 * 2 + hi) ^ (pi & 15)) << 4);
#pragma unroll
    for (int j = 0; j < 4; ++j) voff[j] = 16384 + (r32 >> 1) * 256 + (((((r32 & 1) << 3) + 2 * j + hi) ^ (r32 >> 1)) << 4);

    ATT_DMA(0, 0); ATT_DMA(1, 1);
    asm volatile("s_waitcnt vmcnt(4)" ::: "memory");
    asm volatile("s_waitcnt lgkmcnt(0)" ::: "memory"); __builtin_amdgcn_s_barrier(); asm volatile("" ::: "memory");
    const float bL = lut[0], bR = lut[256];
    f32x16 o[4];
#pragma unroll
    for (int d0 = 0; d0 < 4; ++d0)
#pragma unroll
        for (int r = 0; r < 16; ++r) o[d0][r] = 0.f;
    float mhat = 0.f, l = 0.f;
    bf16x8 pf[4];
#pragma unroll
    for (int j = 0; j < 4; ++j) pf[j] = (bf16x8){0, 0, 0, 0, 0, 0, 0, 0};
    int slot = 0, slotp = 0, slot2 = 2;
#define SBAR() __builtin_amdgcn_sched_barrier(0)
#define EXP2(P, R) do { P[R] = __builtin_amdgcn_exp2f(P[R]); P[(R) + 1] = __builtin_amdgcn_exp2f(P[(R) + 1]); ssum += P[R]; ssum += P[(R) + 1]; asm volatile("" : "+v"(P), "+v"(ssum)); } while (0)
#define CVT8(P, B, J) do { u32x4 x_; x_.x = cvtpk(P[B], P[(B) + 1]); x_.y = cvtpk(P[(B) + 2], P[(B) + 3]); x_.z = cvtpk(P[(B) + 4], P[(B) + 5]); x_.w = cvtpk(P[(B) + 6], P[(B) + 7]); pf[J] = __builtin_bit_cast(bf16x8, x_); asm volatile("" : "+v"(pf[J])); } while (0)
#define VRD(J) do { _Pragma("unroll") for (int d0_ = 0; d0_ < 4; ++d0_) vf[(J) & 1][d0_] = *(const LAS bf16x8*)(pbuf + voff[J] + d0_ * 4096); } while (0)
#define PVM(J, D0) do { __builtin_amdgcn_s_setprio(1); o[D0] = __builtin_amdgcn_mfma_f32_32x32x16_bf16(vf[(J) & 1][D0], pf[J], o[D0], 0, 0, 0); __builtin_amdgcn_s_setprio(0); } while (0)
#define ATT_SCORES() do { \
        const float ci_ = (slow ? 0.f : (farl ? bL : bR)) - mhat; \
        _Pragma("unroll") for (int r = 0; r < 16; ++r) { p0[r] = ci_; p1[r] = ci_; } \
        { bf16x8 ka[4], kb[4]; \
          _Pragma("unroll") for (int d0 = 0; d0 < 4; ++d0) { ka[d0] = *(const LAS bf16x8*)(buf + koff[d0]); kb[d0] = *(const LAS bf16x8*)(buf + koff[d0] + 8192); } \
          SBAR(); \
          __builtin_amdgcn_s_setprio(1); \
          _Pragma("unroll") for (int d0 = 0; d0 < 4; ++d0) { p0 = __builtin_amdgcn_mfma_f32_32x32x16_bf16(ka[d0], qr[d0], p0, 0, 0, 0); p1 = __builtin_amdgcn_mfma_f32_32x32x16_bf16(kb[d0], qr[d0], p1, 0, 0, 0); } \
          __builtin_amdgcn_s_setprio(0); } \
        if (slow) { \
            _Pragma("unroll") for (int r = 0; r < 16; ++r) { const int kv = k0 + (r & 7) + 8 * hi + 16 * (r >> 3); const int rel = kv - q; \
                p0[r] += lut[min(max(rel, -128), 128) + 128]; p1[r] += lut[min(max(rel + 32, -128), 128) + 128]; \
                if (mt) { if (kv >= NMETA) p0[r] = NEG; p1[r] = NEG; } } \
        } \
    } while (0)
#pragma unroll 1
    for (int t = 0; t < NT; ++t) {
        const bool mt = (t == NT - 1); const int k0 = mt ? 0 : NMETA + t * 64; LAS unsigned char* buf = lds + slot * STAGE; LAS unsigned char* pbuf = lds + slotp * STAGE;
        const bool ahead = t + 2 < NT;
        if (ahead) ATT_DMA(t + 2, slot2);
        const int relmax = k0 + 63 - qw0, relmin = k0 - (qw0 + 31);
        const bool farl = relmax <= -91, farr = relmin >= 91;
        const bool slow = !(farl || farr) || mt;
        f32x16 p0, p1;
        ATT_SCORES();
        bf16x8 vf[2][4];
        VRD(0);
        float ssum = 0.f;
        if (t != 0) {
        SBAR();
        VRD(1); SBAR(); PVM(0, 0); EXP2(p0, 0); SBAR(); PVM(0, 1); EXP2(p0, 2); SBAR(); PVM(0, 2); EXP2(p0, 4); SBAR(); PVM(0, 3); EXP2(p0, 6); SBAR();
        VRD(2); SBAR(); PVM(1, 0); EXP2(p0, 8); CVT8(p0, 0, 0); SBAR(); PVM(1, 1); EXP2(p0, 10); SBAR(); PVM(1, 2); EXP2(p0, 12); SBAR(); PVM(1, 3); EXP2(p0, 14); SBAR();
        VRD(3); SBAR(); PVM(2, 0); EXP2(p1, 0); CVT8(p0, 8, 1); SBAR(); PVM(2, 1); EXP2(p1, 2); SBAR(); PVM(2, 2); EXP2(p1, 4); SBAR(); PVM(2, 3); EXP2(p1, 6); SBAR();
        PVM(3, 0); EXP2(p1, 8); CVT8(p1, 0, 2); SBAR(); PVM(3, 1); EXP2(p1, 10); SBAR(); PVM(3, 2); EXP2(p1, 12); SBAR(); PVM(3, 3); EXP2(p1, 14); SBAR();
        CVT8(p1, 8, 3);
        }
        if (t == 0 || __any(!(ssum <= 8192.0f))) {
            if (t != 0) ATT_SCORES();
            float rma = __builtin_fmaxf(__builtin_fmaxf(p0[0], p0[1]), p1[0]), rmb = __builtin_fmaxf(__builtin_fmaxf(p0[2], p0[3]), p1[1]);
            rma = __builtin_fmaxf(__builtin_fmaxf(rma, p1[2]), p1[3]);
#pragma unroll
            for (int r = 4; r < 16; r += 4) { rma = __builtin_fmaxf(__builtin_fmaxf(rma, p0[r]), p0[r + 1]); rmb = __builtin_fmaxf(__builtin_fmaxf(rmb, p0[r + 2]), p0[r + 3]);
                rma = __builtin_fmaxf(__builtin_fmaxf(rma, p1[r]), p1[r + 1]); rmb = __builtin_fmaxf(__builtin_fmaxf(rmb, p1[r + 2]), p1[r + 3]); }
            float rm = __builtin_fmaxf(rma, rmb);
            { auto rr = __builtin_amdgcn_permlane32_swap(__float_as_uint(rm), __float_as_uint(rm), false, false); rm = __builtin_fmaxf(__uint_as_float(rr[0]), __uint_as_float(rr[1])); }
            const float dl = (t == 0) ? rm : fmaxf(rm, 0.f); mhat += dl;
            if (t != 0) { const float fsc = __builtin_amdgcn_exp2f(-dl); l *= fsc;
#pragma unroll
                for (int d0 = 0; d0 < 4; ++d0)
#pragma unroll
                    for (int r = 0; r < 16; ++r) o[d0][r] *= fsc; }
            ssum = 0.f;
#pragma unroll
            for (int r = 0; r < 16; ++r) { p0[r] = __builtin_amdgcn_exp2f(p0[r] - dl); p1[r] = __builtin_amdgcn_exp2f(p1[r] - dl); ssum += p0[r]; ssum += p1[r]; }
            CVT8(p0, 0, 0); CVT8(p0, 8, 1); CVT8(p1, 0, 2); CVT8(p1, 8, 3);
        }
        l += ssum;
        if (ahead) asm volatile("s_waitcnt vmcnt(4)" ::: "memory"); else asm volatile("s_waitcnt vmcnt(0)" ::: "memory");
        asm volatile("s_waitcnt lgkmcnt(0)" ::: "memory"); __builtin_amdgcn_s_barrier(); asm volatile("" ::: "memory");
        slotp = slot; slot = (slot + 1) & 3; slot2 = (slot2 + 1) & 3;
    }
#undef ATT_SCORES
    {
        LAS unsigned char* pbuf = lds + slotp * STAGE; bf16x8 vf[2][4];
        VRD(0);
#pragma unroll
        for (int j = 0; j < 4; ++j) { if (j < 3) VRD((j + 1) & 3); SBAR();
#pragma unroll
            for (int d0 = 0; d0 < 4; ++d0) PVM(j, d0);
            SBAR(); }
    }
    asm volatile("s_waitcnt lgkmcnt(0)" ::: "memory"); __builtin_amdgcn_s_barrier(); asm volatile("" ::: "memory");
#undef SBAR
#undef EXP2
#undef CVT8
#undef VRD
#undef PVM
#undef ATT_DMA
    l += __shfl_xor(l, 32);
    const float inv = 1.0f / l;
    LAS float* comb = (LAS float*)(lds + LDS_COMB) + (w & 3) * 4096 + r32;
    if (c == 1) { const float sc = lam * inv;
#pragma unroll
        for (int d0 = 0; d0 < 4; ++d0)
#pragma unroll
            for (int r = 0; r < 16; ++r) comb[(32 * d0 + (r & 3) + 8 * (r >> 2) + 4 * hi) * 32] = o[d0][r] * sc; }
    __syncthreads();
    if (c == 0) { float ss = 0.f;
#pragma unroll
        for (int d0 = 0; d0 < 4; ++d0)
#pragma unroll
            for (int r = 0; r < 16; ++r) { const float v = o[d0][r] * inv - comb[(32 * d0 + (r & 3) + 8 * (r >> 2) + 4 * hi) * 32]; o[d0][r] = v; ss += v * v; }
        ss += __shfl_xor(ss, 32);
        const float rs = rsqrtf(ss * (1.0f / 128.0f) + EPS) * 0.8f;
        {
            LAS unsigned char* stg = lds + 65536 + (w & 3) * 8704;
#pragma unroll
            for (int d0 = 0; d0 < 4; ++d0)
#pragma unroll
                for (int rg = 0; rg < 4; ++rg) { const int dv = 32 * d0 + 8 * rg; const f32x4 gn = *(const f32x4*)(gain + dv + 4 * hi);
                    u32x2 wv; wv.x = cvt_pk_bf16(o[d0][4 * rg] * rs * gn.x, o[d0][4 * rg + 1] * rs * gn.y); wv.y = cvt_pk_bf16(o[d0][4 * rg + 2] * rs * gn.z, o[d0][4 * rg + 3] * rs * gn.w);
                    *(LAS u32x2*)(stg + r32 * 272 + (dv + 4 * hi) * 2) = wv; }
            asm volatile("s_waitcnt lgkmcnt(0)" ::: "memory");
            bf16_t* op = MIX + (size_t)(rowbase + qw0 - NMETA + (lane >> 4)) * D + h * 128 + (lane & 15) * 8;
#pragma unroll
            for (int i = 0; i < 8; ++i) { const u32x4 v = *(const LAS u32x4*)(stg + (i * 4 + (lane >> 4)) * 272 + (lane & 15) * 16); *(u32x4*)(op + (size_t)(i * 4) * D) = v; }
        }
    }
}

__device__ __forceinline__ void attn_phase(LAS unsigned char* lds, const bf16_t* U3, const bf16_t* VT, bf16_t* MIX, const float* tbl, const float* gain, float lam, unsigned* ctl) {
    volatile LAS int* misc = (volatile LAS int*)(lds + LDS_MISC);
    const int x0 = blockIdx.x & 7;
    for (int qi = 0; qi < 8; ++qi) {
        const int x = (x0 + qi) & 7;
        for (;;) {
            if (threadIdx.x == 0) misc[0] = (int)atomicAdd(ctl + x * 64, 1u);
            __syncthreads();
            const int idx = misc[0];
            __syncthreads();
            if (idx >= UNITS_PER_Q) break;
            int grp, b, h, qb;
            if (idx < 256) { const int i = idx >> 6; qb = idx & 63; const int p = x + 8 * i; grp = 1; b = p >> 2; h = p & 3; }
            else { const int j = idx - 256, i = j >> 4; qb = j & 15; const int p = x + 8 * i; grp = 0; b = p >> 2; h = p & 3; }
            attn_unit(lds, U3, VT, MIX, tbl, gain, lam, grp, b, h, qb);
        }
    }
}
}

__device__ __forceinline__ f32x4 meta_block(const bf16_t* __restrict__ A, int lda, const bf16_t* __restrict__ Bt, int K, int lane) {
    asm volatile("" : "+v"(lane));
    f32x4 acc = (f32x4){0.f, 0.f, 0.f, 0.f};
    const bf16_t* ap = A + (size_t)(lane & 15) * lda + (lane >> 4) * 8; const bf16_t* bp = Bt + (size_t)(lane & 15) * K + (lane >> 4) * 8;
#pragma unroll 8
    for (int k = 0; k < K; k += 32) acc = __builtin_amdgcn_mfma_f32_16x16x32_bf16(*(const bf16x8*)(ap + k), *(const bf16x8*)(bp + k), acc, 0, 0, 0);
    return acc;
}
__device__ __forceinline__ bf16_t bf16_of(float v) { return (bf16_t)(cvt_pk_bf16(v, 0.f) & 0xffffu); }
__device__ __forceinline__ void meta_gateup(const bf16_t* H, const bf16_t* WGU, bf16_t* HFF, const unsigned long long* ssq, int blk, int G, int lane) {
    asm volatile("" : "+v"(lane));
    for (int cb = blk; cb < FF / 16; cb += G) { const int grow = (cb >> 3) * 256 + (cb & 7) * 16;
        const f32x4 g = meta_block(H + (size_t)META0 * D, D, WGU + (size_t)grow * D, D, lane), u = meta_block(H + (size_t)META0 * D, D, WGU + (size_t)(grow + 128) * D, D, lane);
#pragma unroll
        for (int r = 0; r < 4; ++r) { const int row = META0 + 4 * (lane >> 4) + r; const float rs = rstd_of(ssq, row);
            HFF[(size_t)(row - META0) * FF + cb * 16 + (lane & 15)] = bf16_of(pg8::silu_mul(g[r] * rs, u[r] * rs)); } }
}
__device__ __forceinline__ void meta_down(const bf16_t* HFF, const bf16_t* WD, bf16_t* H, unsigned long long* ssq_out, int blk, int G, int lane) {
    asm volatile("" : "+v"(lane));
    for (int cb = blk; cb < D / 16; cb += G) {
        const f32x4 acc = meta_block(HFF, FF, WD + (size_t)cb * 16 * FF, FF, lane);
#pragma unroll
        for (int r = 0; r < 4; ++r) { const int row = META0 + 4 * (lane >> 4) + r; bf16_t* hp = H + (size_t)row * D + cb * 16 + (lane & 15);
            const float v = __uint_as_float((unsigned)*hp << 16) + acc[r]; *hp = bf16_of(v);
            float ss = v * v; ss += __shfl_xor(ss, 1); ss += __shfl_xor(ss, 2); ss += __shfl_xor(ss, 4); ss += __shfl_xor(ss, 8);
            if ((lane & 15) == 0) atomicAdd(ssq_out + row, (unsigned long long)(ss * SSQ_SCALE + 0.5f)); } }
}
__device__ __forceinline__ void meta_win(const bf16_t* H, const bf16_t* WIN, bf16_t* U3, bf16_t* VT, const unsigned long long* ssq, int blk, int G, int lane) {
    asm volatile("" : "+v"(lane));
    for (int cb = blk; cb < 2048 / 16; cb += G) {
        const f32x4 acc = meta_block(H + (size_t)META0 * D, D, WIN + (size_t)cb * 16 * D, D, lane);
#pragma unroll
        for (int r = 0; r < 4; ++r) { const int row = META0 + 4 * (lane >> 4) + r, col = cb * 16 + (lane & 15); const bf16_t v = bf16_of(acc[r] * rstd_of(ssq, row));
            if (col < 1536) U3[(size_t)row * 1536 + col] = v; else VT[(size_t)(col - 1536) * MPAD + row] = v; } }
}

__device__ __forceinline__ void flag_barrier(unsigned* bar, unsigned k) {
    asm volatile("s_waitcnt vmcnt(0)" ::: "memory");
    __syncthreads();
    if (threadIdx.x < 64) {
        const unsigned lane = threadIdx.x, G = gridDim.x;
        if (lane == 0) {
            __builtin_amdgcn_fence(__ATOMIC_RELEASE, "agent");
            asm volatile("s_waitcnt vmcnt(0)" ::: "memory");
            __hip_atomic_store(bar + 64u * (1u + blockIdx.x), k, __ATOMIC_RELAXED, __HIP_MEMORY_SCOPE_AGENT);
        }
        if (blockIdx.x == 0) {
            unsigned sp = 0;
            for (;;) {
                bool ok = true;
                for (unsigned i = lane; i < G; i += 64) ok = ok && (__hip_atomic_load(bar + 64u * (1u + i), __ATOMIC_RELAXED, __HIP_MEMORY_SCOPE_AGENT) >= k);
                if (__all(ok)) break;
                __builtin_amdgcn_s_sleep(1);
                if (++sp > (1u << 18)) break;
            }
            if (lane == 0) __hip_atomic_store(bar, k, __ATOMIC_RELAXED, __HIP_MEMORY_SCOPE_AGENT);
        }
        if (lane == 0) {
            unsigned sp = 0;
            while (__hip_atomic_load(bar, __ATOMIC_RELAXED, __HIP_MEMORY_SCOPE_AGENT) < k) { __builtin_amdgcn_s_sleep(1); if (++sp > (1u << 20)) break; }
            __builtin_amdgcn_fence(__ATOMIC_ACQUIRE, "agent");
            asm volatile("s_waitcnt vmcnt(0)" ::: "memory");
        }
    }
    __syncthreads();
}

__global__ void __launch_bounds__(512, 2) mk_fwd(Args a) {
    extern __shared__ __attribute__((aligned(16))) unsigned char lds_raw[];
    LAS unsigned char* lds = (LAS unsigned char*)lds_raw;
    cg::grid_group grid = cg::this_grid();
    const int tid = threadIdx.x, lane = tid & 63, wave = __builtin_amdgcn_readfirstlane(tid >> 6);
    const int G = gridDim.x, gw = blockIdx.x * 8 + wave, NGW = G * 8;
    unsigned char* ws = a.ws;
    bf16_t* H = (bf16_t*)(ws + WS_H); unsigned char* HFF = ws + WS_BIG; bf16_t* HFFM = (bf16_t*)(ws + WS_HFFM); bf16_t* U3 = (bf16_t*)(ws + WS_U3); bf16_t* VT = (bf16_t*)(ws + WS_VT); bf16_t* MIX = (bf16_t*)(ws + WS_MIX);
    unsigned long long* SSQ0 = (unsigned long long*)(ws + WS_SSQ); unsigned long long* SSQ1 = SSQ0 + 131072; unsigned long long* SSQ2 = SSQ0 + 2 * 131072; unsigned long long* SSQ3 = SSQ0 + 3 * 131072;
    const int lo = a.ph_lo, hi = a.ph_hi;
#define IN(k) (lo <= (k) && (k) < hi)
#define SEAM(k) do { if (IN(k) && IN((k) + 1)) { if ((k) == 0) grid.sync(); else flag_barrier((unsigned*)(ws + WS_BAR), (unsigned)(k)); } } while (0)

    if (IN(0)) prologue(a, lds, gw, NGW, lane, wave);
#ifdef PROBE_DUP_MISC
    if (IN(0)) { __syncthreads(); prologue(a, lds, gw, NGW, lane, wave); }
#endif
    SEAM(0);
#pragma unroll 1
    for (int pass = 0; pass < 2; ++pass) {
        const int pu = pass ? 6 : 1, pd = pass ? 7 : 2;
        if (IN(pu)) {
            if (pass == 0 && wave == 0) meta_gateup(H, (const bf16_t*)(ws + WS_WGU1), HFFM, SSQ0, (int)blockIdx.x, G, lane);
            pg8::Gemm g{(const bf16_t*)(ws + WS_H8), (const bf16_t*)(ws + (pass ? WS_WGU2_8 : WS_WGU1_8)), NREAL, 2 * FF, D / 2}; pg8::StaticOrder S; S.init(NREAL, 2 * FF, G, (int)blockIdx.x);
            pg8::EpiGateUp E{HFF, pass ? SSQ2 : SSQ0, 1.0f / W8_SCALE};
            pg8::gemm_phase<pg8::EpiGateUp, pg8::StaticOrder, true>(lds, g, S, E);
#ifdef PROBE_DUP_GU
            if (pass == 0) pg8::gemm_phase<pg8::EpiGateUp, pg8::StaticOrder>(lds, g, S, E);
#endif
        }
        SEAM(pu);
        if (IN(pd)) {
            if (pass == 0 && wave == 0) meta_down(HFFM, (const bf16_t*)(ws + WS_WD1), H, SSQ1, (int)blockIdx.x, G, lane);
            pg8::Gemm g{(const bf16_t*)HFF, (const bf16_t*)(ws + (pass ? WS_WD2_8 : WS_WD1_8)), NREAL, D, FF / 2}; pg8::StaticOrder S; S.init(NREAL, D, G, (int)blockIdx.x);
            pg8::EpiResid E{H, pass ? SSQ3 : SSQ1, nullptr, 1.0f / (HFF8_SCALE * WD8_SCALE)};
            pg8::gemm_phase<pg8::EpiResid, pg8::StaticOrder, true>(lds, g, S, E);
        }
        SEAM(pd);
        if (pass == 0) {
            if (IN(3)) {
                if (wave == 0) meta_win(H, (const bf16_t*)(ws + WS_WIN), U3, VT, SSQ1, (int)blockIdx.x, G, lane);
                { pg8::Gemm g{H, (const bf16_t*)(ws + WS_WIN), NREAL, 1536, D}; pg8::StaticOrder S; S.init(NREAL, 1536, G, (int)blockIdx.x);
                  pg8::EpiRowScale E{U3, 1536, SSQ1};
                  pg8::gemm_phase<pg8::EpiRowScale, pg8::StaticOrder>(lds, g, S, E); }
                { pg8::Gemm g{(const bf16_t*)(ws + WS_WIN) + (size_t)1536 * D, H, 512, NREAL, D}; pg8::StaticOrder S; S.init(512, NREAL, G, (int)blockIdx.x);
                  pg8::EpiColScale E{VT, MPAD, SSQ1};
                  pg8::gemm_phase<pg8::EpiColScale, pg8::StaticOrder>(lds, g, S, E); }
            }
            SEAM(3);
            if (IN(4)) {
                pool_phase(U3, MIX, gw, NGW, lane);
#ifdef PROBE_DUP_MISC
                pool_phase(U3, MIX, gw, NGW, lane);
#endif
                int ll = lane; asm volatile("" : "+v"(ll));
                const float s1 = wave_sum(a.in[10][ll] * a.in[11][ll]), s2 = wave_sum(a.in[12][ll] * a.in[13][ll]);
                const float lam = __expf(s1) - __expf(s2) + 0.2f;
                att::attn_phase(lds, U3, VT, MIX, a.in[3], a.in[14], lam, (unsigned*)(ws + WS_CTL));
#ifdef PROBE_DUP_ATT
                att::attn_phase(lds, U3, VT, MIX, a.in[3], a.in[14], lam, (unsigned*)(ws + WS_CTL) + 8 * 64);
#endif
            }
            SEAM(4);
            if (IN(5)) {
                pg8::Gemm g{MIX, (const bf16_t*)(ws + WS_WOUT), NREAL, D, D}; pg8::StaticOrder S; S.init(NREAL, D, G, (int)blockIdx.x);
                pg8::EpiResid E{H, SSQ2, ws + WS_H8, 1.0f};
                pg8::gemm_phase<pg8::EpiResid, pg8::StaticOrder>(lds, g, S, E);
            }
            SEAM(5);
        }
    }
    if (IN(8)) {
        const float* gf = a.in[22];
        for (int orow0 = gw * 4; orow0 < NOUT_ROWS; orow0 += NGW * 4) {
            u32x4 hv[4][2]; float rs[4];
#pragma unroll
            for (int i = 0; i < 4; ++i) { const int row = orow0 + i;
                rs[i] = rstd_of(SSQ3, row);
#pragma unroll
                for (int j = 0; j < 2; ++j) hv[i][j] = *(const u32x4*)(H + (size_t)row * D + (j * 64 + lane) * 8); }
#pragma unroll
            for (int j = 0; j < 2; ++j) { const int col = (j * 64 + lane) * 8; const f32x4 g0 = *(const f32x4*)(gf + col), g1 = *(const f32x4*)(gf + col + 4);
#pragma unroll
                for (int i = 0; i < 4; ++i) { const u32x4 h4 = hv[i][j]; const float r = rs[i];
                    f32x4 o0, o1; o0.x = bf_lo(h4.x) * r * g0.x; o0.y = bf_hi(h4.x) * r * g0.y; o0.z = bf_lo(h4.y) * r * g0.z; o0.w = bf_hi(h4.y) * r * g0.w;
                    o1.x = bf_lo(h4.z) * r * g1.x; o1.y = bf_hi(h4.z) * r * g1.y; o1.z = bf_lo(h4.w) * r * g1.z; o1.w = bf_hi(h4.w) * r * g1.w;
                    float* op = a.out + (size_t)(orow0 + i) * D + col; *(f32x4*)op = o0; *(f32x4*)(op + 4) = o1; } }
        }
    }
#undef IN
#undef SEAM
}

constexpr int LDS_BYTES = 147456;
extern "C" void kernel_launch(void* const* d_in, const int* in_sizes, int n_in, void* d_out, int out_size, void* d_ws, size_t ws_size, hipStream_t stream) {
    static int grid = 0;
    if (grid == 0) {
        if (n_in != 23 || out_size != NOUT_ROWS * D || ws_size < WS_END) { fprintf(stderr, "kernel_launch: unexpected shapes (n_in %d, out %d, ws %zu < %zu)\n", n_in, out_size, ws_size, (size_t)WS_END); grid = -1; return; }
        int dev = 0, cus = 0, per_cu = 0;
        (void)hipGetDevice(&dev); (void)hipDeviceGetAttribute(&cus, hipDeviceAttributeMultiprocessorCount, dev);
        (void)hipFuncSetAttribute((const void*)mk_fwd, hipFuncAttributeMaxDynamicSharedMemorySize, LDS_BYTES);
        if (hipOccupancyMaxActiveBlocksPerMultiprocessor(&per_cu, (const void*)mk_fwd, 512, LDS_BYTES) != hipSuccess || per_cu < 1) per_cu = 1;
        (void)hipGetLastError();
        grid = cus * 1;
        if (grid <= 0) grid = 256;
    }
    if (grid < 0) return;
    Args a{};
    for (int i = 0; i < 23; ++i) a.in[i] = (const float*)d_in[i];
    a.out = (float*)d_out; a.ws = (unsigned char*)d_ws;
#if MK_MULTI
    for (int p = 0; p < 9; ++p) { a.ph_lo = p; a.ph_hi = p + 1; hipLaunchKernelGGL(mk_fwd, dim3(grid), dim3(512), LDS_BYTES, stream, a); }
#else
    a.ph_lo = 0; a.ph_hi = 9;
    void* args[] = {&a};
    hipError_t e = hipLaunchCooperativeKernel((const void*)mk_fwd, dim3(grid), dim3(512), args, LDS_BYTES, stream);
    if (e != hipSuccess) fprintf(stderr, "cooperative launch failed: %s (grid %d)\n", hipGetErrorString(e), grid);
#endif
}
```

```cpp
#include <hip/hip_runtime.h>
#include <hip/hip_cooperative_groups.h>
#include <cstdio>
#include <cstdint>
namespace cg = cooperative_groups;

#ifndef MK_MULTI
#define MK_MULTI 0
#endif

#define LAS __attribute__((address_space(3)))
typedef unsigned short bf16_t;
typedef short bf16x8 __attribute__((ext_vector_type(8)));
typedef float f32x4 __attribute__((ext_vector_type(4)));
typedef float f32x16 __attribute__((ext_vector_type(16)));
typedef unsigned u32x4 __attribute__((ext_vector_type(4)));
typedef unsigned u32x2 __attribute__((ext_vector_type(2)));

constexpr int D = 1024, FF = 2816, NMETA = 16;
constexpr int NB1 = 16, S1 = 2048, NB2 = 8, S2 = 8192;
constexpr int L1 = S1 + NMETA, L2 = S2 + NMETA;
constexpr int M1 = NB1 * L1, M2 = NB2 * L2;
constexpr int MTOK = M1 + M2;
constexpr int MPAD = 98816;
constexpr int NOUT_ROWS = NB1 * S1 + NB2 * S2;
constexpr int NREAL = NOUT_ROWS, META0 = NREAL;
constexpr float EPS = 1e-6f;
constexpr float LOG2E = 1.4426950408889634f;
constexpr float C2 = 0.125f * LOG2E;
constexpr float SSQ_SCALE = 1048576.0f;

constexpr size_t MiB = 1u << 20;
constexpr size_t WS_CTL = 0;
constexpr size_t WS_BAR = 512 * 1024;
constexpr size_t WS_SSQ = 1 * MiB;
constexpr size_t WS_WGU1 = 8 * MiB, WS_WD1 = 20 * MiB, WS_WIN = 26 * MiB, WS_WOUT = 30 * MiB, WS_WGU2 = 32 * MiB, WS_WD2 = 44 * MiB;
constexpr size_t WS_H = 50 * MiB;
constexpr size_t WS_BIG = 243 * MiB;
constexpr size_t WS_U3 = WS_BIG;
constexpr size_t WS_VT = WS_BIG + (size_t)MPAD * 1536 * 2;
constexpr size_t WS_MIX = WS_VT + (size_t)512 * MPAD * 2;
constexpr size_t WS_H8 = WS_MIX + (size_t)MPAD * 1024 * 2;
constexpr size_t WS_WGU1_8 = WS_H8 + (size_t)MPAD * 1024, WS_WGU2_8 = WS_WGU1_8 + (size_t)2 * FF * D;
constexpr size_t WS_WD1_8 = WS_WGU2_8 + (size_t)2 * FF * D, WS_WD2_8 = WS_WD1_8 + (size_t)D * FF;
constexpr size_t WS_WV8 = WS_WD2_8 + (size_t)D * FF;
constexpr size_t WS_END = WS_WV8 + (size_t)512 * D;
constexpr size_t WS_HFFM = 128 * 1024;
constexpr float W8_SCALE = 64.0f, HFF8_SCALE = 8.0f, WD8_SCALE = 128.0f;
static_assert(WS_H + (size_t)MPAD * 2048 <= WS_BIG && WS_BIG + (size_t)MPAD * FF * 2 <= WS_H8, "ws map");
static_assert(WS_END <= 1024 * MiB, "ws map exceeds 1 GiB");

__device__ __forceinline__ unsigned cvt_pk_bf16(float lo, float hi) { unsigned r; asm volatile("v_cvt_pk_bf16_f32 %0, %1, %2" : "=v"(r) : "v"(lo), "v"(hi)); return r; }
typedef int i32x4 __attribute__((ext_vector_type(4)));
typedef int i32x8 __attribute__((ext_vector_type(8)));
__device__ __forceinline__ float clamp8(float v) { return __builtin_fminf(__builtin_fmaxf(v, -448.0f), 448.0f); }
__device__ __forceinline__ unsigned pk4_fp8(float a, float b, float c, float d) { int w = 0; w = __builtin_amdgcn_cvt_pk_fp8_f32(clamp8(a), clamp8(b), w, false); w = __builtin_amdgcn_cvt_pk_fp8_f32(clamp8(c), clamp8(d), w, true); return (unsigned)w; }
__device__ __forceinline__ float bf_lo(unsigned u) { return __uint_as_float(u << 16); }
__device__ __forceinline__ float bf_hi(unsigned u) { return __uint_as_float(u & 0xffff0000u); }
__device__ __forceinline__ float rstd_of(const unsigned long long* ssq, int row) { return rsqrtf((float)ssq[row] * (1.0f / (SSQ_SCALE * 1024.0f)) + EPS); }
__device__ __forceinline__ float wave_sum(float v) {
#pragma unroll
    for (int o = 1; o < 64; o <<= 1) v += __shfl_xor(v, o);
    return v;
}

namespace pg8 {
constexpr int BM = 256, BK = 64, HALF = 128, HTB = HALF * BK * 2, STAGE_BYTES = 8 * HTB, NXCD = 8, WGM = 8;
__host__ __device__ __forceinline__ int lds_byte(int r, int c) { const int st = (r >> 4) * 2 + (c >> 5), rr = r & 15, cc = c & 31, ob = rr * 64 + cc * 2; return st * 1024 + (ob ^ (((ob >> 9) & 1) << 5)); }
__host__ __device__ __forceinline__ void stage_rc(int b, int& R, int& C) { const int st = b / 1024, sb = b % 1024, swz = sb ^ (((sb >> 9) & 1) << 5); R = (st >> 1) * 16 + swz / 64; C = (st & 1) * 32 + (swz % 64) / 2; }
__host__ __device__ __forceinline__ int perm32(int rho) { const int n = rho >> 4, i = rho & 15; return 8 * (i >> 2) + 4 * n + (i & 3); }

struct Unit { int pm, pn; };
template <bool F8> struct FragSel { typedef bf16x8 type; };
template <> struct FragSel<true> { typedef i32x8 type; };
struct Gemm { const bf16_t* A; const bf16_t* Bt; int M, N, K; };

struct StaticOrder {
    int nM, nN, nwg, G, c;
    __host__ __device__ void init(int M, int N, int G_, int c_) { nM = M / BM; nN = N / BM; nwg = nM * nN; G = G_; c = c_; }
    __host__ __device__ bool next(int i, Unit& u) const {
        const long L = (long)i * G + c; if (L >= nwg) return false;
        int wgid = (int)L; { const int q = nwg / NXCD, r = nwg % NXCD, xcd = wgid % NXCD, off = wgid / NXCD; wgid = (xcd < r ? xcd * (q + 1) : r * (q + 1) + (xcd - r) * q) + off; }
        const int nig = WGM * nN, gid = wgid / nig, fm = gid * WGM, gsz = (nM - fm) < WGM ? (nM - fm) : WGM;
        u.pm = fm + ((wgid % nig) % gsz); u.pn = (wgid % nig) / gsz; return true;
    }
};

template <class Epi, class Sched, bool F8 = false>
__device__ __forceinline__ void gemm_phase(LAS unsigned char* lds, const Gemm g, const Sched& S, const Epi& E) {
    int tid = threadIdx.x; asm volatile("" : "+v"(tid));
    const int wid = __builtin_amdgcn_readfirstlane(tid >> 6), lane = tid & 63, wr = wid >> 2, wc = wid & 3, fr = lane & 15, fq = lane >> 4;
    using FragT = typename FragSel<F8>::type; constexpr int NKF = F8 ? 1 : 2;
    unsigned sc1 = 0x7F7F7F7Fu; asm volatile("" : "+v"(sc1));
    const int K = g.K, nt = K / BK;
    unsigned voffA[2], voffB[2];
#pragma unroll
    for (int i = 0; i < 2; ++i) { int R, C; stage_rc(tid * 16 + i * 8192, R, C); const int Rb = (R & ~31) + perm32(R & 31);
        voffA[i] = (unsigned)(R * K + C) * 2u; voffB[i] = (unsigned)(Rb * K + C) * 2u; }
    asm volatile("" : "+v"(voffA[0]), "+v"(voffA[1]), "+v"(voffB[0]), "+v"(voffB[1]));
    const size_t kstep = (size_t)(BK * 2);
    const size_t hstep = (size_t)HALF * K * 2;
    const size_t tstep = 2 * hstep;
    const unsigned ldsw = (unsigned)wid * 1024u;
    const int aoff = lds_byte(wr * 64 + fr, fq * 8), boff = lds_byte(wc * 32 + fr, fq * 8);
#define PG8_SA(b, h) (((b) * 2 + (h)) * HTB)
#define PG8_SB(b, h) ((4 + (b) * 2 + (h)) * HTB)
#define PG8_STAGE(bufoff, gbase, voff) do { _Pragma("unroll") for (int _i = 0; _i < 2; ++_i) \
        __builtin_amdgcn_global_load_lds((const unsigned*)((const char*)(gbase) + (voff)[_i]), (LAS unsigned*)(lds + (bufoff) + ldsw + _i * 8192), 16, 0, 0); } while (0)
#define PG8_LD1(dst, addr) do { if constexpr (F8) { dst[0] = __builtin_shufflevector(*(const LAS i32x4*)(addr), *(const LAS i32x4*)((addr) + 1024), 0, 1, 2, 3, 4, 5, 6, 7); } \
        else { _Pragma("unroll") for (int k = 0; k < NKF; ++k) dst[k] = *(const LAS FragT*)((addr) + k * 1024); } } while (0)
#define PG8_LDA(dst, b, h) do { _Pragma("unroll") for (int m = 0; m < 4; ++m) PG8_LD1(dst[m], lds + PG8_SA(b, h) + aoff + m * 2048); } while (0)
#define PG8_LDB(dst, b, h) do { _Pragma("unroll") for (int n = 0; n < 2; ++n) PG8_LD1(dst[n], lds + PG8_SB(b, h) + boff + n * 2048); } while (0)
#define PG8_MMA(ai, bj, At, Bt) do { __builtin_amdgcn_s_setprio(1); _Pragma("unroll") for (int m = 0; m < 4; ++m) _Pragma("unroll") for (int n = 0; n < 2; ++n) { \
        if constexpr (F8) { asm volatile("v_mfma_scale_f32_16x16x128_f8f6f4 %0, %1, %2, %0, %3, %3 op_sel_hi:[0,0,0]" : "+v"(acc[ai][bj][m][n]) : "v"(Bt[n][0]), "v"(At[m][0]), "v"(sc1)); } \
        else { _Pragma("unroll") for (int k = 0; k < 2; ++k) acc[ai][bj][m][n] = __builtin_amdgcn_mfma_f32_16x16x32_bf16(Bt[n][k], At[m][k], acc[ai][bj][m][n], 0, 0, 0); } } \
        __builtin_amdgcn_s_setprio(0); } while (0)
#define PG8_WAIT_V(n) asm volatile("s_waitcnt vmcnt(" #n ")" ::: "memory")
#define PG8_WAIT_L(n) asm volatile("s_waitcnt lgkmcnt(" #n ")" ::: "memory")
#define PG8_BAR __builtin_amdgcn_s_barrier()
#define PG8_SCHED __builtin_amdgcn_sched_barrier(0)
    Unit cur, nxt; int ui = 0;
    if (!S.next(0, cur)) return;
    f32x4 acc[2][2][4][2];
#pragma unroll
    for (int a = 0; a < 2; ++a)
#pragma unroll
        for (int b = 0; b < 2; ++b)
#pragma unroll
            for (int m = 0; m < 4; ++m)
#pragma unroll
                for (int n = 0; n < 2; ++n) acc[a][b][m][n] = (f32x4){0.f, 0.f, 0.f, 0.f};
    FragT At[4][NKF], B0[2][NKF], B1[2][NKF];
    unsigned long long pfv[8];
    const char* cA = (const char*)g.A + (size_t)cur.pm * tstep; const char* cB = (const char*)g.Bt + (size_t)cur.pn * tstep;
    PG8_STAGE(PG8_SB(0, 0), cB, voffB); PG8_STAGE(PG8_SB(0, 1), cB + hstep, voffB); PG8_STAGE(PG8_SA(0, 0), cA, voffA); PG8_STAGE(PG8_SA(0, 1), cA + hstep, voffA);
    if (wr == 1) PG8_BAR;
    PG8_WAIT_V(2); PG8_BAR;
    PG8_STAGE(PG8_SB(1, 0), cB + kstep, voffB); PG8_STAGE(PG8_SA(1, 0), cA + kstep, voffA); PG8_STAGE(PG8_SB(1, 1), cB + hstep + kstep, voffB);
    PG8_WAIT_V(6); PG8_BAR;
    for (;;) {
        const bool has_next = S.next(ui + 1, nxt);
        const char* nA = has_next ? (const char*)g.A + (size_t)nxt.pm * tstep : cA; const char* nB = has_next ? (const char*)g.Bt + (size_t)nxt.pn * tstep : cB;
#pragma unroll 1
        for (int t = 0; t < nt; t += 2) {
            const bool last = (t == nt - 2);
            if constexpr (Epi::PREF) { if (last) E.prefetch(pfv, cur, wr, fr); }
            const char* a1 = cA + (size_t)(t + 1) * kstep;
            const char* a2 = last ? nA : cA + (size_t)(t + 2) * kstep; const char* b2 = last ? nB : cB + (size_t)(t + 2) * kstep;
            const char* a3 = a2 + kstep; const char* b3 = b2 + kstep;
            PG8_LDB(B0, 0, 0); PG8_LDB(B1, 0, 1); PG8_SCHED; PG8_LDA(At, 0, 0); PG8_STAGE(PG8_SA(1, 1), a1 + hstep, voffA);
            PG8_WAIT_V(8); PG8_WAIT_L(0); PG8_BAR; PG8_MMA(0, 0, At, B0); PG8_MMA(0, 1, At, B1); PG8_BAR; PG8_SCHED;
            PG8_LDA(At, 0, 1); PG8_STAGE(PG8_SB(0, 0), b2, voffB); PG8_STAGE(PG8_SB(0, 1), b2 + hstep, voffB); PG8_STAGE(PG8_SA(0, 0), a2, voffA);
            PG8_WAIT_V(8); PG8_WAIT_L(0); PG8_BAR; PG8_MMA(1, 0, At, B0); PG8_MMA(1, 1, At, B1); PG8_BAR; PG8_SCHED;
            PG8_LDB(B0, 1, 0); PG8_LDB(B1, 1, 1); PG8_SCHED; PG8_LDA(At, 1, 0); PG8_STAGE(PG8_SA(0, 1), a2 + hstep, voffA);
            PG8_WAIT_V(8); PG8_WAIT_L(0); PG8_BAR; PG8_MMA(0, 0, At, B0); PG8_MMA(0, 1, At, B1); PG8_BAR; PG8_SCHED;
            PG8_LDA(At, 1, 1); PG8_STAGE(PG8_SB(1, 0), b3, voffB); PG8_STAGE(PG8_SB(1, 1), b3 + hstep, voffB); PG8_STAGE(PG8_SA(1, 0), a3, voffA);
            PG8_WAIT_V(8); PG8_WAIT_L(0); PG8_BAR; PG8_MMA(1, 0, At, B0); PG8_MMA(1, 1, At, B1); PG8_BAR; PG8_SCHED;
        }
        if (wr == 0) PG8_BAR;
        if constexpr (F8) { asm volatile("s_nop 15\n\ts_nop 7" ::: "memory"); PG8_SCHED; }
        if constexpr (Epi::PREF) E(acc, cur, wr, wc, fr, fq, pfv); else E(acc, cur, wr, wc, fr, fq);
        if (!has_next) break;
#pragma unroll
        for (int a = 0; a < 2; ++a)
#pragma unroll
            for (int b = 0; b < 2; ++b)
#pragma unroll
                for (int m = 0; m < 4; ++m)
#pragma unroll
                    for (int n = 0; n < 2; ++n) acc[a][b][m][n] = (f32x4){0.f, 0.f, 0.f, 0.f};
        cur = nxt; cA = nA; cB = nB; ++ui;
        if (wr == 1) PG8_BAR;
    }
    PG8_WAIT_V(0);
    PG8_BAR;
#undef PG8_SA
#undef PG8_SB
#undef PG8_STAGE
#undef PG8_LDA
#undef PG8_LD1
#undef PG8_LDB
#undef PG8_MMA
#undef PG8_WAIT_V
#undef PG8_WAIT_L
#undef PG8_BAR
#undef PG8_SCHED
}

__device__ __forceinline__ float silu_mul(float g, float u) { return g * __builtin_amdgcn_rcpf(1.0f + __builtin_amdgcn_exp2f(-g * LOG2E)) * u; }
struct EpiGateUp {
    static constexpr bool PREF = true;
    unsigned char* O; const unsigned long long* ssq; float wsc;
    __device__ __forceinline__ void prefetch(unsigned long long (&pf)[8], const Unit& u, int wr, int fr) const {
        const int row0 = u.pm * BM + wr * 64 + fr;
#pragma unroll
        for (int ai = 0; ai < 2; ++ai)
#pragma unroll
            for (int m = 0; m < 4; ++m) pf[ai * 4 + m] = ssq[row0 + ai * HALF + m * 16];
    }
    __device__ __forceinline__ void operator()(const f32x4 (&acc)[2][2][4][2], const Unit& u, int wr, int wc, int fr, int fq, const unsigned long long (&pf)[8]) const {
        const int row0 = u.pm * BM + wr * 64 + fr, col0 = u.pn * HALF + wc * 32 + 8 * fq;
#pragma unroll
        for (int ai = 0; ai < 2; ++ai)
#pragma unroll
            for (int m = 0; m < 4; ++m) { const int row = row0 + ai * HALF + m * 16; const float rs = rsqrtf((float)pf[ai * 4 + m] * (1.0f / (SSQ_SCALE * 1024.0f)) + EPS) * wsc;
                const f32x4 g0 = acc[ai][0][m][0] * rs, g1 = acc[ai][0][m][1] * rs, u0 = acc[ai][1][m][0] * rs, u1 = acc[ai][1][m][1] * rs;
                u32x2 w; w.x = pk4_fp8(silu_mul(g0[0], u0[0]) * HFF8_SCALE, silu_mul(g0[1], u0[1]) * HFF8_SCALE, silu_mul(g0[2], u0[2]) * HFF8_SCALE, silu_mul(g0[3], u0[3]) * HFF8_SCALE);
                w.y = pk4_fp8(silu_mul(g1[0], u1[0]) * HFF8_SCALE, silu_mul(g1[1], u1[1]) * HFF8_SCALE, silu_mul(g1[2], u1[2]) * HFF8_SCALE, silu_mul(g1[3], u1[3]) * HFF8_SCALE);
                *(u32x2*)(O + (size_t)row * FF + col0) = w; }
    }
};
struct EpiResid {
    static constexpr bool PREF = false;
    bf16_t* H; unsigned long long* ssq_out; unsigned char* H8; float asc;
    __device__ __forceinline__ void operator()(const f32x4 (&acc)[2][2][4][2], const Unit& u, int wr, int wc, int fr, int fq) const {
        const int row0 = u.pm * BM + wr * 64 + fr, col0 = u.pn * BM + wc * 32 + 8 * fq;
#pragma unroll
        for (int ai = 0; ai < 2; ++ai)
#pragma unroll
            for (int m = 0; m < 4; ++m) { const int row = row0 + ai * HALF + m * 16; float ss = 0.f;
#pragma unroll
                for (int bj = 0; bj < 2; ++bj) { bf16_t* p = H + (size_t)row * D + col0 + bj * HALF; const u32x4 hv = *(const u32x4*)p;
                    const f32x4 a0 = acc[ai][bj][m][0] * asc, a1 = acc[ai][bj][m][1] * asc;
                    const float v0 = bf_lo(hv.x) + a0[0], v1 = bf_hi(hv.x) + a0[1], v2 = bf_lo(hv.y) + a0[2], v3 = bf_hi(hv.y) + a0[3];
                    const float v4 = bf_lo(hv.z) + a1[0], v5 = bf_hi(hv.z) + a1[1], v6 = bf_lo(hv.w) + a1[2], v7 = bf_hi(hv.w) + a1[3];
                    ss += (v0 * v0 + v1 * v1) + (v2 * v2 + v3 * v3) + (v4 * v4 + v5 * v5) + (v6 * v6 + v7 * v7);
                    u32x4 w; w.x = cvt_pk_bf16(v0, v1); w.y = cvt_pk_bf16(v2, v3); w.z = cvt_pk_bf16(v4, v5); w.w = cvt_pk_bf16(v6, v7);
                    *(u32x4*)p = w;
                    if (H8) { u32x2 w8; w8.x = pk4_fp8(v0, v1, v2, v3); w8.y = pk4_fp8(v4, v5, v6, v7); *(u32x2*)(H8 + (size_t)row * D + col0 + bj * HALF) = w8; } }
                ss += __shfl_xor(ss, 16); ss += __shfl_xor(ss, 32);
                if (fq == 0) atomicAdd(ssq_out + row, (unsigned long long)(ss * SSQ_SCALE + 0.5f)); }
    }
};
struct EpiRowScale {
    static constexpr bool PREF = false;
    bf16_t* O; int ldc; const unsigned long long* ssq;
    __device__ __forceinline__ void operator()(const f32x4 (&acc)[2][2][4][2], const Unit& u, int wr, int wc, int fr, int fq) const {
        const int row0 = u.pm * BM + wr * 64 + fr, col0 = u.pn * BM + wc * 32 + 8 * fq;
#pragma unroll
        for (int ai = 0; ai < 2; ++ai)
#pragma unroll
            for (int m = 0; m < 4; ++m) { const int row = row0 + ai * HALF + m * 16; const float rs = rstd_of(ssq, row);
#pragma unroll
                for (int bj = 0; bj < 2; ++bj) { const f32x4 v0 = acc[ai][bj][m][0] * rs, v1 = acc[ai][bj][m][1] * rs;
                    u32x4 w; w.x = cvt_pk_bf16(v0[0], v0[1]); w.y = cvt_pk_bf16(v0[2], v0[3]); w.z = cvt_pk_bf16(v1[0], v1[1]); w.w = cvt_pk_bf16(v1[2], v1[3]);
                    *(u32x4*)(O + (size_t)row * ldc + col0 + bj * HALF) = w; } }
    }
};
struct EpiColScale {
    static constexpr bool PREF = false;
    bf16_t* O; int ldc; const unsigned long long* ssq; float wsc;
    __device__ __forceinline__ void operator()(const f32x4 (&acc)[2][2][4][2], const Unit& u, int wr, int wc, int fr, int fq) const {
        const int row0 = u.pm * BM + wr * 64 + fr, col0 = u.pn * BM + wc * 32 + 8 * fq;
#pragma unroll
        for (int bj = 0; bj < 2; ++bj) {
            float rs[8];
#pragma unroll
            for (int j = 0; j < 8; ++j) rs[j] = rstd_of(ssq, col0 + bj * HALF + j) * wsc;
#pragma unroll
            for (int ai = 0; ai < 2; ++ai)
#pragma unroll
                for (int m = 0; m < 4; ++m) { const int row = row0 + ai * HALF + m * 16; const f32x4 v0 = acc[ai][bj][m][0], v1 = acc[ai][bj][m][1];
                    u32x4 w; w.x = cvt_pk_bf16(v0[0] * rs[0], v0[1] * rs[1]); w.y = cvt_pk_bf16(v0[2] * rs[2], v0[3] * rs[3]);
                    w.z = cvt_pk_bf16(v1[0] * rs[4], v1[1] * rs[5]); w.w = cvt_pk_bf16(v1[2] * rs[6], v1[3] * rs[7]);
                    *(u32x4*)(O + (size_t)row * ldc + col0 + bj * HALF) = w; }
        }
    }
};
}

template <int MODE>
__device__ __forceinline__ void tr2_item(const float* __restrict__ W, int ldw, int k0, int n0, bf16_t* __restrict__ WT, unsigned char* __restrict__ WT8, int ldt, int dst_row0, int dst_k0,
                                         const float* __restrict__ ks, float cs, float cs8, LAS float* scr, int lane) {
    f32x4 v[16];
#pragma unroll
    for (int i = 0; i < 16; ++i) { const int r = 2 * i + (lane >> 5); v[i] = *(const f32x4*)(W + (size_t)(k0 + r) * ldw + n0 + (lane & 31) * 4); }
#pragma unroll
    for (int i = 0; i < 16; ++i) { const int r = 2 * i + (lane >> 5); const float sc = ks ? ks[k0 + r] : 1.0f; LAS float* d = scr + r * 129 + (lane & 31) * 4;
        d[0] = v[i].x * sc; d[1] = v[i].y * sc; d[2] = v[i].z * sc; d[3] = v[i].w * sc; }
    asm volatile("s_waitcnt lgkmcnt(0)" ::: "memory");
    if constexpr (MODE != 0) { const int c = lane & 1;
#pragma unroll
        for (int j = 0; j < 4; ++j) { const int n = (lane >> 1) + 32 * j; const LAS float* s = scr + (16 * c) * 129 + n;
            u32x4 o; o.x = pk4_fp8(s[0 * 129] * cs8, s[1 * 129] * cs8, s[2 * 129] * cs8, s[3 * 129] * cs8); o.y = pk4_fp8(s[4 * 129] * cs8, s[5 * 129] * cs8, s[6 * 129] * cs8, s[7 * 129] * cs8);
            o.z = pk4_fp8(s[8 * 129] * cs8, s[9 * 129] * cs8, s[10 * 129] * cs8, s[11 * 129] * cs8); o.w = pk4_fp8(s[12 * 129] * cs8, s[13 * 129] * cs8, s[14 * 129] * cs8, s[15 * 129] * cs8);
            *(u32x4*)(WT8 + (size_t)(dst_row0 + n) * ldt + dst_k0 + k0 + 16 * c) = o; }
    }
    if constexpr (MODE != 1) { const int c = lane & 3;
#pragma unroll
        for (int j = 0; j < 8; ++j) { const int n = (lane >> 2) + 16 * j; const LAS float* s = scr + (8 * c) * 129 + n;
            u32x4 o; o.x = cvt_pk_bf16(s[0 * 129] * cs, s[1 * 129] * cs); o.y = cvt_pk_bf16(s[2 * 129] * cs, s[3 * 129] * cs); o.z = cvt_pk_bf16(s[4 * 129] * cs, s[5 * 129] * cs); o.w = cvt_pk_bf16(s[6 * 129] * cs, s[7 * 129] * cs);
            *(u32x4*)(WT + (size_t)(dst_row0 + n) * ldt + dst_k0 + k0 + 8 * c) = o; }
    }
    asm volatile("s_waitcnt lgkmcnt(0)" ::: "memory");
}

struct Args { const float* in[23]; float* out; unsigned char* ws; int ph_lo, ph_hi; };

__device__ __forceinline__ void prologue(const Args& a, LAS unsigned char* lds, int gw, int NGW, int lane, int wave) {
    asm volatile("" : "+v"(lane));
    unsigned char* ws = a.ws;
    LAS float* scr = (LAS float*)(lds + wave * 16512);
    bf16_t* WGU1 = (bf16_t*)(ws + WS_WGU1); bf16_t* WD1 = (bf16_t*)(ws + WS_WD1); bf16_t* WIN = (bf16_t*)(ws + WS_WIN); bf16_t* WOUT = (bf16_t*)(ws + WS_WOUT);
    constexpr int I_GU = (D / 32) * (FF / 128), I_DN = (FF / 32) * (D / 128), I_IN = (D / 32) * (2048 / 128), I_OUT = (512 / 32) * (D / 128);
    constexpr int NITEMS = 6 * I_GU + I_IN + I_OUT;
    static_assert(I_GU == I_DN, "item counts");
#ifdef PROBE_DUP_W
    for (int rep_ = 0; rep_ < 2; ++rep_)
#endif
    for (int it = gw; it < NITEMS; it += NGW) {
        int r = it;
        if (r < 6 * I_GU) {
            const int which = r / I_GU; r -= which * I_GU; const int layer = which / 3, kind = which % 3;
            if (kind < 2) { const int nblk = FF / 128, kb = r / nblk, nb = r % nblk, n0 = nb * 128; const int drow = nb * 256 + kind * 128;
                if (layer) tr2_item<1>(a.in[19 + kind], FF, kb * 32, n0, nullptr, ws + WS_WGU2_8, D, drow, 0, a.in[18], 1.0f, W8_SCALE, scr, lane);
                else tr2_item<2>(a.in[5 + kind], FF, kb * 32, n0, WGU1, ws + WS_WGU1_8, D, drow, 0, a.in[4], 1.0f, W8_SCALE, scr, lane);
            } else { const int nblk = D / 128, kb = r / nblk, nb = r % nblk, n0 = nb * 128;
                if (layer) tr2_item<1>(a.in[21], D, kb * 32, n0, nullptr, ws + WS_WD2_8, FF, n0, 0, nullptr, 0.5f, 0.5f * WD8_SCALE, scr, lane);
                else tr2_item<2>(a.in[7], D, kb * 32, n0, WD1, ws + WS_WD1_8, FF, n0, 0, nullptr, 0.5f, 0.5f * WD8_SCALE, scr, lane); }
            continue;
        }
        r -= 6 * I_GU;
        if (r < I_IN) { const int nblk = 2048 / 128, kb = r / nblk, nb = r % nblk, n0 = nb * 128;
            const int drow = n0 < 1024 ? n0 : (n0 < 1536 ? n0 + 512 : n0 - 512);
            tr2_item<0>(a.in[9], 2048, kb * 32, n0, WIN, nullptr, D, drow, 0, a.in[8], n0 < 512 ? C2 : 1.0f, 0.f, scr, lane);
            if (n0 >= 1024 && n0 < 1536) tr2_item<1>(a.in[9], 2048, kb * 32, n0, nullptr, ws + WS_WV8, D, n0 - 1024, 0, a.in[8], 1.0f, W8_SCALE, scr, lane);
            continue; }
        r -= I_IN;
        { const int nblk = D / 128, kb = r / nblk, nb = r % nblk, n0 = nb * 128;
          tr2_item<0>(a.in[17], D, kb * 32, n0, WOUT, nullptr, D, n0, 0, nullptr, 1.0f, 0.f, scr, lane); }
    }
    for (int it = gw; it < 2048; it += NGW) {
        const int g = it >> 9, nb = (it >> 5) & 15, cb = it & 31, n = nb * 64 + lane;
        const float* pw = a.in[15] + (size_t)(g * 128 + cb * 4) * 128; const float* ps = a.in[16] + g * 128; const float* wo = a.in[17] + (size_t)(512 + g * 128) * D + n;
        float acc[4] = {0.f, 0.f, 0.f, 0.f};
#pragma unroll 32
        for (int d = 0; d < 128; ++d) { const float w = wo[(size_t)d * D] * ps[d];
#pragma unroll
            for (int c = 0; c < 4; ++c) acc[c] += pw[c * 128 + d] * w; }
        u32x2 o0; o0.x = cvt_pk_bf16(acc[0], acc[1]); o0.y = cvt_pk_bf16(acc[2], acc[3]);
        *(u32x2*)(WOUT + (size_t)n * D + 512 + g * 128 + cb * 4) = o0;
    }
    bf16_t* H = (bf16_t*)(ws + WS_H); unsigned long long* SSQ = (unsigned long long*)(ws + WS_SSQ);
    for (int row0 = gw * 4; row0 < MPAD; row0 += NGW * 4) {
        f32x4 v[4][4];
#pragma unroll
        for (int i = 0; i < 4; ++i) { const int row = row0 + i;
            if (row < NREAL + NMETA) { const float* src = row < NB1 * S1 ? a.in[0] + (size_t)row * D : (row < NREAL ? a.in[1] + (size_t)(row - NB1 * S1) * D : a.in[2] + (size_t)(row - NREAL) * D);
#pragma unroll
                for (int j = 0; j < 4; ++j) v[i][j] = ((const f32x4*)src)[lane + 64 * j];
            } else {
#pragma unroll
                for (int j = 0; j < 4; ++j) v[i][j] = (f32x4){0.f, 0.f, 0.f, 0.f};
            } }
#pragma unroll
        for (int i = 0; i < 4; ++i) { const int row = row0 + i; float s = 0.f;
#pragma unroll
            for (int j = 0; j < 4; ++j) s += (v[i][j].x * v[i][j].x + v[i][j].y * v[i][j].y) + (v[i][j].z * v[i][j].z + v[i][j].w * v[i][j].w);
            s = wave_sum(s);
            u32x2* o8 = (u32x2*)(H + (size_t)row * D) + lane;
#pragma unroll
            for (int j = 0; j < 4; ++j) { u32x2 w; w.x = cvt_pk_bf16(v[i][j].x, v[i][j].y); w.y = cvt_pk_bf16(v[i][j].z, v[i][j].w); o8[64 * j] = w;
                ((unsigned*)(ws + WS_H8 + (size_t)row * D))[lane + 64 * j] = pk4_fp8(v[i][j].x, v[i][j].y, v[i][j].z, v[i][j].w); }
            if (lane == 0) { SSQ[row] = (unsigned long long)(s * SSQ_SCALE + 0.5f); SSQ[131072 + row] = 0ull; SSQ[2 * 131072 + row] = 0ull; SSQ[3 * 131072 + row] = 0ull; } }
    }
    if (gw == 0 && lane < 16) ((unsigned*)(ws + WS_CTL))[lane * 64] = 0u;
    if (blockIdx.x == 0) { for (int i = threadIdx.x; i < 257; i += 512) ((unsigned*)(ws + WS_BAR))[64 * i] = 0u; }
    {
        static_assert((size_t)NREAL * FF <= (size_t)(META0 + NMETA) * 1536 * 2, "hff (fp8, real rows only) must end below the zeroed U3 rows");
        bf16_t* U3z = (bf16_t*)(ws + WS_U3) + (size_t)(META0 + NMETA) * 1536; bf16_t* VTz = (bf16_t*)(ws + WS_VT) + META0 + NMETA;
        const u32x4 z4 = (u32x4){0u, 0u, 0u, 0u};
        for (int i = gw * 64 + lane; i < 48 * 1536 / 8; i += NGW * 64) *(u32x4*)(U3z + (size_t)i * 8) = z4;
        for (int i = gw * 64 + lane; i < 512 * 6; i += NGW * 64) *(u32x4*)(VTz + (size_t)(i / 6) * MPAD + (i % 6) * 8) = z4;
    }
}

__device__ __forceinline__ void pool_acc(float (&sum)[8], const u32x4 x, float sgn) {
    sum[0] += sgn * bf_lo(x.x); sum[1] += sgn * bf_hi(x.x); sum[2] += sgn * bf_lo(x.y); sum[3] += sgn * bf_hi(x.y);
    sum[4] += sgn * bf_lo(x.z); sum[5] += sgn * bf_hi(x.z); sum[6] += sgn * bf_lo(x.w); sum[7] += sgn * bf_hi(x.w); }
__device__ __forceinline__ void pool_phase(const bf16_t* __restrict__ U3, bf16_t* __restrict__ MIX, unsigned* ctr, int lane) {
    asm volatile("" : "+v"(lane));
    constexpr int NTASK = NREAL / 8;
    static_assert(NTASK % 16 == 0, "pool task chunks");
    const int g = lane >> 4, w2 = 1 << g, col = lane * 8;
    const u32x4 z4 = (u32x4){0u, 0u, 0u, 0u};
    const bf16_t* xcol = U3 + 1024 + col;
    for (;;) {
        int base = 0; if (lane == 0) base = (int)atomicAdd(ctr, 16u);
        base = __builtin_amdgcn_readfirstlane(base);
        if (base >= NTASK) break;
    for (int task = base; task < base + 16; ++task) {
        const int r0 = task * 8; int seqbase, L;
        if (r0 < NB1 * S1) { seqbase = r0 & ~(S1 - 1); L = L1; } else { seqbase = NB1 * S1 + ((r0 - NB1 * S1) & ~(S2 - 1)); L = L2; }
        const int t0 = r0 - seqbase + NMETA;
#define XROW(tt) (xcol + (size_t)((tt) < NMETA ? META0 + (tt) : seqbase + (tt) - NMETA) * 1536)
        u32x4 wv[16];
#pragma unroll
        for (int j = 0; j < 16; ++j) { const int tt = t0 - 8 + j; wv[j] = (j >= 8 - w2 && j < 8 + w2 && tt >= 0 && tt < L) ? *(const u32x4*)XROW(tt) : z4; }
        float sum[8];
#pragma unroll
        for (int e = 0; e < 8; ++e) sum[e] = 0.f;
#pragma unroll
        for (int j = 0; j < 16; ++j) pool_acc(sum, wv[j], 1.0f);
        u32x4 xc[8], xa[8], xs[8];
#pragma unroll
        for (int i = 0; i < 8; ++i) { const int t = t0 + i; xc[i] = *(const u32x4*)XROW(t);
            xa[i] = (t + w2 < L) ? *(const u32x4*)XROW(t + w2) : z4; xs[i] = (t - w2 >= 0) ? *(const u32x4*)XROW(t - w2) : z4; }
#pragma unroll
        for (int i = 0; i < 8; ++i) { const int t = t0 + i; const int lo = max(t - w2, 0), hi = min(t + w2, L); const float inv = 1.0f / (float)(hi - lo);
            const u32x4 x = xc[i];
            u32x4 o; o.x = cvt_pk_bf16(sum[0] * inv - bf_lo(x.x), sum[1] * inv - bf_hi(x.x)); o.y = cvt_pk_bf16(sum[2] * inv - bf_lo(x.y), sum[3] * inv - bf_hi(x.y));
            o.z = cvt_pk_bf16(sum[4] * inv - bf_lo(x.z), sum[5] * inv - bf_hi(x.z)); o.w = cvt_pk_bf16(sum[6] * inv - bf_lo(x.w), sum[7] * inv - bf_hi(x.w));
            *(u32x4*)(MIX + (size_t)(r0 + i) * D + 512 + col) = o;
            pool_acc(sum, xa[i], 1.0f); pool_acc(sum, xs[i], -1.0f); }
    }
    }
#undef XROW
}

namespace att {
constexpr int STAGE = 32768;
constexpr int LDS_COMB = 0;
constexpr int LDS_LUT = 131072;
constexpr int LDS_MISC = 131072 + 2048;
constexpr float NEG = -1.0e30f;
constexpr int UNITS_PER_Q = 4 * 64 + 8 * 16;

__device__ __forceinline__ unsigned cvtpk(float lo, float hi) { typedef float f2 __attribute__((ext_vector_type(2))); typedef __bf16 b2 __attribute__((ext_vector_type(2)));
    f2 v = {lo, hi}; b2 b = __builtin_convertvector(v, b2); return __builtin_bit_cast(unsigned, b); }

__device__ __forceinline__ void attn_unit(LAS unsigned char* lds, const bf16_t* __restrict__ U3, const bf16_t* __restrict__ VT, bf16_t* __restrict__ MIX,
                                          const float* __restrict__ tbl, const float* __restrict__ gain, float lam, int grp, int b, int h, int qb) {
    int tid = threadIdx.x; asm volatile("" : "+v"(tid));
    const int lane = tid & 63, r32 = lane & 31, hi = lane >> 5;
    const int w = __builtin_amdgcn_readfirstlane(tid >> 6), c = w >> 2;
    const int S = grp ? S2 : S1, rowbase = grp ? NB1 * S1 + b * S2 : b * S1, NT = (S >> 6) + 1;
    const int qw0 = NMETA + qb * 128 + (w & 3) * 32, q = qw0 + r32;
    LAS float* lut = (LAS float*)(lds + LDS_LUT);
    if (tid < 257) { const int rel = tid - 128, n = rel < 0 ? -rel : rel;
        int bk = n < 8 ? n : 8 + (n >= 12) + (n >= 16) + (n >= 23) + (n >= 32) + (n >= 46) + (n >= 64) + (n >= 91);
        if (rel > 0) bk += 16;
        lut[tid] = tbl[bk * 4 + h] * LOG2E; }
    bf16x8 qr[4];
    { const bf16_t* qp = U3 + (size_t)(rowbase + q - NMETA) * 1536 + h * 128 + c * 64 + hi * 8;
#pragma unroll
      for (int d0 = 0; d0 < 4; ++d0) qr[d0] = *(const bf16x8*)(qp + d0 * 16); }
    const bf16_t* kg[2]; const bf16_t* vg[2];
#pragma unroll
    for (int i = 0; i < 2; ++i) { const int row = 4 * (i * 8 + w) + (lane >> 4), kch = (lane & 15) ^ (row & 15);
        kg[i] = U3 + (size_t)row * 1536 + 512 + h * 128 + kch * 8;
        const int rp = row, p = (lane & 15) ^ (rp & 15), dv = 2 * rp + (p >> 3), ch = p & 7;
        vg[i] = VT + (size_t)(h * 128 + dv) * MPAD + ch * 8; }
#define ATT_DMA(T, SLOT) do { LAS unsigned char* sb_ = lds + (SLOT) * STAGE + w * 1024; const int tr_ = ((T) < NT - 1) ? rowbase + (T) * 64 : META0; \
        __builtin_amdgcn_global_load_lds((const unsigned*)(kg[0] + (size_t)tr_ * 1536), (LAS unsigned*)(sb_), 16, 0, 0); \
        __builtin_amdgcn_global_load_lds((const unsigned*)(kg[1] + (size_t)tr_ * 1536), (LAS unsigned*)(sb_ + 8192), 16, 0, 0); \
        __builtin_amdgcn_global_load_lds((const unsigned*)(vg[0] + tr_), (LAS unsigned*)(sb_ + 16384), 16, 0, 0); \
        __builtin_amdgcn_global_load_lds((const unsigned*)(vg[1] + tr_), (LAS unsigned*)(sb_ + 24576), 16, 0, 0); } while (0)
    const int pi = (r32 & 0x13) | ((r32 & 4) << 1) | ((r32 & 8) >> 1);
    unsigned koff[4], voff[4];
#pragma unroll
    for (int d0 = 0; d0 < 4; ++d0) koff[d0] = pi * 256 + (((c * 8 + d0 * 2 + hi) ^ (pi & 15)) << 4);
#pragma unroll
    for (int j = 0; j < 4; ++j) voff[j] = 16384 + (r32 >> 1) * 256 + (((((r32 & 1) << 3) + 2 * j + hi) ^ (r32 >> 1)) << 4);

    ATT_DMA(0, 0); ATT_DMA(1, 1);
    asm volatile("s_waitcnt vmcnt(4)" ::: "memory");
    asm volatile("s_waitcnt lgkmcnt(0)" ::: "memory"); __builtin_amdgcn_s_barrier(); asm volatile("" ::: "memory");
    const float bL = lut[0], bR = lut[256];
    f32x16 o[4];
#pragma unroll
    for (int d0 = 0; d0 < 4; ++d0)
#pragma unroll
        for (int r = 0; r < 16; ++r) o[d0][r] = 0.f;
    float mhat = 0.f, l = 0.f;
    bf16x8 pf[4];
#pragma unroll
    for (int j = 0; j < 4; ++j) pf[j] = (bf16x8){0, 0, 0, 0, 0, 0, 0, 0};
    int slot = 0, slotp = 0, slot2 = 2;
#define SBAR() __builtin_amdgcn_sched_barrier(0)
#define EXP2(P, R) do { P[R] = __builtin_amdgcn_exp2f(P[R]); P[(R) + 1] = __builtin_amdgcn_exp2f(P[(R) + 1]); ssum += P[R]; ssum += P[(R) + 1]; asm volatile("" : "+v"(P), "+v"(ssum)); } while (0)
#define CVT8(P, B, J) do { u32x4 x_; x_.x = cvtpk(P[B], P[(B) + 1]); x_.y = cvtpk(P[(B) + 2], P[(B) + 3]); x_.z = cvtpk(P[(B) + 4], P[(B) + 5]); x_.w = cvtpk(P[(B) + 6], P[(B) + 7]); pf[J] = __builtin_bit_cast(bf16x8, x_); asm volatile("" : "+v"(pf[J])); } while (0)
#define VRD(J) do { _Pragma("unroll") for (int d0_ = 0; d0_ < 4; ++d0_) vf[(J) & 1][d0_] = *(const LAS bf16x8*)(pbuf + voff[J] + d0_ * 4096); } while (0)
#define PVM(J, D0) do { __builtin_amdgcn_s_setprio(1); o[D0] = __builtin_amdgcn_mfma_f32_32x32x16_bf16(vf[(J) & 1][D0], pf[J], o[D0], 0, 0, 0); __builtin_amdgcn_s_setprio(0); } while (0)
#define ATT_SCORES() do { \
        const float ci_ = (slow ? 0.f : (farl ? bL : bR)) - mhat; \
        _Pragma("unroll") for (int r = 0; r < 16; ++r) { p0[r] = ci_; p1[r] = ci_; } \
        { bf16x8 ka[4], kb[4]; \
          _Pragma("unroll") for (int d0 = 0; d0 < 4; ++d0) { ka[d0] = *(const LAS bf16x8*)(buf + koff[d0]); kb[d0] = *(const LAS bf16x8*)(buf + koff[d0] + 8192); } \
          SBAR(); \
          __builtin_amdgcn_s_setprio(1); \
          _Pragma("unroll") for (int d0 = 0; d0 < 4; ++d0) { p0 = __builtin_amdgcn_mfma_f32_32x32x16_bf16(ka[d0], qr[d0], p0, 0, 0, 0); p1 = __builtin_amdgcn_mfma_f32_32x32x16_bf16(kb[d0], qr[d0], p1, 0, 0, 0); } \
          __builtin_amdgcn_s_setprio(0); } \
        if (slow) { \
            _Pragma("unroll") for (int r = 0; r < 16; ++r) { const int kv = k0 + (r & 7) + 8 * hi + 16 * (r >> 3); const int rel = kv - q; \
                p0[r] += lut[min(max(rel, -128), 128) + 128]; p1[r] += lut[min(max(rel + 32, -128), 128) + 128]; \
                if (mt) { if (kv >= NMETA) p0[r] = NEG; p1[r] = NEG; } } \
        } \
    } while (0)
#pragma unroll 1
    for (int t = 0; t < NT; ++t) {
        const bool mt = (t == NT - 1); const int k0 = mt ? 0 : NMETA + t * 64; LAS unsigned char* buf = lds + slot * STAGE; LAS unsigned char* pbuf = lds + slotp * STAGE;
        const bool ahead = t + 2 < NT;
        if (ahead) ATT_DMA(t + 2, slot2);
        const int relmax = k0 + 63 - qw0, relmin = k0 - (qw0 + 31);
        const bool farl = relmax <= -91, farr = relmin >= 91;
        const bool slow = !(farl || farr) || mt;
        f32x16 p0, p1;
        ATT_SCORES();
        bf16x8 vf[2][4];
        VRD(0);
        float ssum = 0.f;
        if (t != 0) {
        SBAR();
        VRD(1); SBAR(); PVM(0, 0); EXP2(p0, 0); SBAR(); PVM(0, 1); EXP2(p0, 2); SBAR(); PVM(0, 2); EXP2(p0, 4); SBAR(); PVM(0, 3); EXP2(p0, 6); SBAR();
        VRD(2); SBAR(); PVM(1, 0); EXP2(p0, 8); CVT8(p0, 0, 0); SBAR(); PVM(1, 1); EXP2(p0, 10); SBAR(); PVM(1, 2); EXP2(p0, 12); SBAR(); PVM(1, 3); EXP2(p0, 14); SBAR();
        VRD(3); SBAR(); PVM(2, 0); EXP2(p1, 0); CVT8(p0, 8, 1); SBAR(); PVM(2, 1); EXP2(p1, 2); SBAR(); PVM(2, 2); EXP2(p1, 4); SBAR(); PVM(2, 3); EXP2(p1, 6); SBAR();
        PVM(3, 0); EXP2(p1, 8); CVT8(p1, 0, 2); SBAR(); PVM(3, 1); EXP2(p1, 10); SBAR(); PVM(3, 2); EXP2(p1, 12); SBAR(); PVM(3, 3); EXP2(p1, 14); SBAR();
        CVT8(p1, 8, 3);
        }
        if (t == 0 || __any(!(ssum <= 8192.0f))) {
            if (t != 0) ATT_SCORES();
            float rma = __builtin_fmaxf(__builtin_fmaxf(p0[0], p0[1]), p1[0]), rmb = __builtin_fmaxf(__builtin_fmaxf(p0[2], p0[3]), p1[1]);
            rma = __builtin_fmaxf(__builtin_fmaxf(rma, p1[2]), p1[3]);
#pragma unroll
            for (int r = 4; r < 16; r += 4) { rma = __builtin_fmaxf(__builtin_fmaxf(rma, p0[r]), p0[r + 1]); rmb = __builtin_fmaxf(__builtin_fmaxf(rmb, p0[r + 2]), p0[r + 3]);
                rma = __builtin_fmaxf(__builtin_fmaxf(rma, p1[r]), p1[r + 1]); rmb = __builtin_fmaxf(__builtin_fmaxf(rmb, p1[r + 2]), p1[r + 3]); }
            float rm = __builtin_fmaxf(rma, rmb);
            { auto rr = __builtin_amdgcn_permlane32_swap(__float_as_uint(rm), __float_as_uint(rm), false, false); rm = __builtin_fmaxf(__uint_as_float(rr[0]), __uint_as_float(rr[1])); }
            const float dl = (t == 0) ? rm : fmaxf(rm, 0.f); mhat += dl;
            if (t != 0) { const float fsc = __builtin_amdgcn_exp2f(-dl); l *= fsc;
#pragma unroll
                for (int d0 = 0; d0 < 4; ++d0)
#pragma unroll
                    for (int r = 0; r < 16; ++r) o[d0][r] *= fsc; }
            ssum = 0.f;
#pragma unroll
            for (int r = 0; r < 16; ++r) { p0[r] = __builtin_amdgcn_exp2f(p0[r] - dl); p1[r] = __builtin_amdgcn_exp2f(p1[r] - dl); ssum += p0[r]; ssum += p1[r]; }
            CVT8(p0, 0, 0); CVT8(p0, 8, 1); CVT8(p1, 0, 2); CVT8(p1, 8, 3);
        }
        l += ssum;
        if (ahead) asm volatile("s_waitcnt vmcnt(4)" ::: "memory"); else asm volatile("s_waitcnt vmcnt(0)" ::: "memory");
        asm volatile("s_waitcnt lgkmcnt(0)" ::: "memory"); __builtin_amdgcn_s_barrier(); asm volatile("" ::: "memory");
        slotp = slot; slot = (slot + 1) & 3; slot2 = (slot2 + 1) & 3;
    }
#undef ATT_SCORES
    {
        LAS unsigned char* pbuf = lds + slotp * STAGE; bf16x8 vf[2][4];
        VRD(0);
#pragma unroll
        for (int j = 0; j < 4; ++j) { if (j < 3) VRD((j + 1) & 3); SBAR();
#pragma unroll
            for (int d0 = 0; d0 < 4; ++d0) PVM(j, d0);
            SBAR(); }
    }
    asm volatile("s_waitcnt lgkmcnt(0)" ::: "memory"); __builtin_amdgcn_s_barrier(); asm volatile("" ::: "memory");
#undef SBAR
#undef EXP2
#undef CVT8
#undef VRD
#undef PVM
#undef ATT_DMA
    l += __shfl_xor(l, 32);
    const float inv = 1.0f / l;
    LAS float* comb = (LAS float*)(lds + LDS_COMB) + (w & 3) * 4096 + r32;
    if (c == 1) { const float sc = lam * inv;
#pragma unroll
        for (int d0 = 0; d0 < 4; ++d0)
#pragma unroll
            for (int r = 0; r < 16; ++r) comb[(32 * d0 + (r & 3) + 8 * (r >> 2) + 4 * hi) * 32] = o[d0][r] * sc; }
    __syncthreads();
    if (c == 0) { float ss = 0.f;
#pragma unroll
        for (int d0 = 0; d0 < 4; ++d0)
#pragma unroll
            for (int r = 0; r < 16; ++r) { const float v = o[d0][r] * inv - comb[(32 * d0 + (r & 3) + 8 * (r >> 2) + 4 * hi) * 32]; o[d0][r] = v; ss += v * v; }
        ss += __shfl_xor(ss, 32);
        const float rs = rsqrtf(ss * (1.0f / 128.0f) + EPS) * 0.8f;
        {
            LAS unsigned char* stg = lds + 65536 + (w & 3) * 8704;
#pragma unroll
            for (int d0 = 0; d0 < 4; ++d0)
#pragma unroll
                for (int rg = 0; rg < 4; ++rg) { const int dv = 32 * d0 + 8 * rg; const f32x4 gn = *(const f32x4*)(gain + dv + 4 * hi);
                    u32x2 wv; wv.x = cvt_pk_bf16(o[d0][4 * rg] * rs * gn.x, o[d0][4 * rg + 1] * rs * gn.y); wv.y = cvt_pk_bf16(o[d0][4 * rg + 2] * rs * gn.z, o[d0][4 * rg + 3] * rs * gn.w);
                    *(LAS u32x2*)(stg + r32 * 272 + (dv + 4 * hi) * 2) = wv; }
            asm volatile("s_waitcnt lgkmcnt(0)" ::: "memory");
            bf16_t* op = MIX + (size_t)(rowbase + qw0 - NMETA + (lane >> 4)) * D + h * 128 + (lane & 15) * 8;
#pragma unroll
            for (int i = 0; i < 8; ++i) { const u32x4 v = *(const LAS u32x4*)(stg + (i * 4 + (lane >> 4)) * 272 + (lane & 15) * 16); *(u32x4*)(op + (size_t)(i * 4) * D) = v; }
        }
    }
}

__device__ __forceinline__ void attn_phase(LAS unsigned char* lds, const bf16_t* U3, const bf16_t* VT, bf16_t* MIX, const float* tbl, const float* gain, float lam, unsigned* ctl) {
    volatile LAS int* misc = (volatile LAS int*)(lds + LDS_MISC);
    const int x0 = blockIdx.x & 7;
    for (int qi = 0; qi < 8; ++qi) {
        const int x = (x0 + qi) & 7;
        for (;;) {
            if (threadIdx.x == 0) misc[0] = (int)atomicAdd(ctl + x * 64, 1u);
            __syncthreads();
            const int idx = misc[0];
            __syncthreads();
            if (idx >= UNITS_PER_Q) break;
            int grp, b, h, qb;
            if (idx < 256) { const int i = idx >> 6; qb = idx & 63; const int p = x + 8 * i; grp = 1; b = p >> 2; h = p & 3; }
            else { const int j = idx - 256, i = j >> 4; qb = j & 15; const int p = x + 8 * i; grp = 0; b = p >> 2; h = p & 3; }
            attn_unit(lds, U3, VT, MIX, tbl, gain, lam, grp, b, h, qb);
        }
    }
}
}

__device__ __forceinline__ f32x4 meta_block(const bf16_t* __restrict__ A, int lda, const bf16_t* __restrict__ Bt, int K, int lane) {
    asm volatile("" : "+v"(lane));
    f32x4 acc = (f32x4){0.f, 0.f, 0.f, 0.f};
    const bf16_t* ap = A + (size_t)(lane & 15) * lda + (lane >> 4) * 8; const bf16_t* bp = Bt + (size_t)(lane & 15) * K + (lane >> 4) * 8;
#pragma unroll 8
    for (int k = 0; k < K; k += 32) acc = __builtin_amdgcn_mfma_f32_16x16x32_bf16(*(const bf16x8*)(ap + k), *(const bf16x8*)(bp + k), acc, 0, 0, 0);
    return acc;
}
__device__ __forceinline__ bf16_t bf16_of(float v) { return (bf16_t)(cvt_pk_bf16(v, 0.f) & 0xffffu); }
__device__ __forceinline__ void meta_gateup(const bf16_t* H, const bf16_t* WGU, bf16_t* HFF, const unsigned long long* ssq, int blk, int G, int lane) {
    asm volatile("" : "+v"(lane));
    for (int cb = blk; cb < FF / 16; cb += G) { const int grow = (cb >> 3) * 256 + (cb & 7) * 16;
        const f32x4 g = meta_block(H + (size_t)META0 * D, D, WGU + (size_t)grow * D, D, lane), u = meta_block(H + (size_t)META0 * D, D, WGU + (size_t)(grow + 128) * D, D, lane);
#pragma unroll
        for (int r = 0; r < 4; ++r) { const int row = META0 + 4 * (lane >> 4) + r; const float rs = rstd_of(ssq, row);
            HFF[(size_t)(row - META0) * FF + cb * 16 + (lane & 15)] = bf16_of(pg8::silu_mul(g[r] * rs, u[r] * rs)); } }
}
__device__ __forceinline__ void meta_down(const bf16_t* HFF, const bf16_t* WD, bf16_t* H, unsigned long long* ssq_out, int blk, int G, int lane) {
    asm volatile("" : "+v"(lane));
    for (int cb = blk; cb < D / 16; cb += G) {
        const f32x4 acc = meta_block(HFF, FF, WD + (size_t)cb * 16 * FF, FF, lane);
#pragma unroll
        for (int r = 0; r < 4; ++r) { const int row = META0 + 4 * (lane >> 4) + r; bf16_t* hp = H + (size_t)row * D + cb * 16 + (lane & 15);
            const float v = __uint_as_float((unsigned)*hp << 16) + acc[r]; *hp = bf16_of(v);
            float ss = v * v; ss += __shfl_xor(ss, 1); ss += __shfl_xor(ss, 2); ss += __shfl_xor(ss, 4); ss += __shfl_xor(ss, 8);
            if ((lane & 15) == 0) atomicAdd(ssq_out + row, (unsigned long long)(ss * SSQ_SCALE + 0.5f)); } }
}
__device__ __forceinline__ void meta_win(const bf16_t* H, const bf16_t* WIN, bf16_t* U3, bf16_t* VT, const unsigned long long* ssq, int blk, int G, int lane) {
    asm volatile("" : "+v"(lane));
    for (int cb = blk; cb < 2048 / 16; cb += G) {
        const f32x4 acc = meta_block(H + (size_t)META0 * D, D, WIN + (size_t)cb * 16 * D, D, lane);
#pragma unroll
        for (int r = 0; r < 4; ++r) { const int row = META0 + 4 * (lane >> 4) + r, col = cb * 16 + (lane & 15); const bf16_t v = bf16_of(acc[r] * rstd_of(ssq, row));
            if (col < 1536) U3[(size_t)row * 1536 + col] = v; else VT[(size_t)(col - 1536) * MPAD + row] = v; } }
}

__device__ __forceinline__ void flag_barrier(unsigned* bar, unsigned k) {
    asm volatile("s_waitcnt vmcnt(0)" ::: "memory");
    __syncthreads();
    if (threadIdx.x < 64) {
        const unsigned lane = threadIdx.x, G = gridDim.x;
        if (lane == 0) {
            __builtin_amdgcn_fence(__ATOMIC_RELEASE, "agent");
            asm volatile("s_waitcnt vmcnt(0)" ::: "memory");
            __hip_atomic_store(bar + 64u * (1u + blockIdx.x), k, __ATOMIC_RELAXED, __HIP_MEMORY_SCOPE_AGENT);
        }
        if (blockIdx.x == 0) {
            unsigned sp = 0;
            for (;;) {
                bool ok = true;
                for (unsigned i = lane; i < G; i += 64) ok = ok && (__hip_atomic_load(bar + 64u * (1u + i), __ATOMIC_RELAXED, __HIP_MEMORY_SCOPE_AGENT) >= k);
                if (__all(ok)) break;
                __builtin_amdgcn_s_sleep(1);
                if (++sp > (1u << 18)) break;
            }
            if (lane == 0) __hip_atomic_store(bar, k, __ATOMIC_RELAXED, __HIP_MEMORY_SCOPE_AGENT);
        }
        if (lane == 0) {
            unsigned sp = 0;
            while (__hip_atomic_load(bar, __ATOMIC_RELAXED, __HIP_MEMORY_SCOPE_AGENT) < k) { __builtin_amdgcn_s_sleep(1); if (++sp > (1u << 20)) break; }
            __builtin_amdgcn_fence(__ATOMIC_ACQUIRE, "agent");
            asm volatile("s_waitcnt vmcnt(0)" ::: "memory");
        }
    }
    __syncthreads();
}

__global__ void __launch_bounds__(512, 2) mk_fwd(Args a) {
    extern __shared__ __attribute__((aligned(16))) unsigned char lds_raw[];
    LAS unsigned char* lds = (LAS unsigned char*)lds_raw;
    cg::grid_group grid = cg::this_grid();
    const int tid = threadIdx.x, lane = tid & 63, wave = __builtin_amdgcn_readfirstlane(tid >> 6);
    const int G = gridDim.x, gw = blockIdx.x * 8 + wave, NGW = G * 8;
    unsigned char* ws = a.ws;
    bf16_t* H = (bf16_t*)(ws + WS_H); unsigned char* HFF = ws + WS_BIG; bf16_t* HFFM = (bf16_t*)(ws + WS_HFFM); bf16_t* U3 = (bf16_t*)(ws + WS_U3); bf16_t* VT = (bf16_t*)(ws + WS_VT); bf16_t* MIX = (bf16_t*)(ws + WS_MIX);
    unsigned long long* SSQ0 = (unsigned long long*)(ws + WS_SSQ); unsigned long long* SSQ1 = SSQ0 + 131072; unsigned long long* SSQ2 = SSQ0 + 2 * 131072; unsigned long long* SSQ3 = SSQ0 + 3 * 131072;
    const int lo = a.ph_lo, hi = a.ph_hi;
#define IN(k) (lo <= (k) && (k) < hi)
#define SEAM(k) do { if (IN(k) && IN((k) + 1)) { if ((k) == 0) grid.sync(); else flag_barrier((unsigned*)(ws + WS_BAR), (unsigned)(k)); } } while (0)

    if (IN(0)) prologue(a, lds, gw, NGW, lane, wave);
#ifdef PROBE_DUP_MISC
    if (IN(0)) { __syncthreads(); prologue(a, lds, gw, NGW, lane, wave); }
#endif
    SEAM(0);
#pragma unroll 1
    for (int pass = 0; pass < 2; ++pass) {
        const int pu = pass ? 6 : 1, pd = pass ? 7 : 2;
        if (IN(pu)) {
            if (pass == 0 && wave == 0) meta_gateup(H, (const bf16_t*)(ws + WS_WGU1), HFFM, SSQ0, (int)blockIdx.x, G, lane);
            pg8::Gemm g{(const bf16_t*)(ws + WS_H8), (const bf16_t*)(ws + (pass ? WS_WGU2_8 : WS_WGU1_8)), NREAL, 2 * FF, D / 2}; pg8::StaticOrder S; S.init(NREAL, 2 * FF, G, (int)blockIdx.x);
            pg8::EpiGateUp E{HFF, pass ? SSQ2 : SSQ0, 1.0f / W8_SCALE};
            pg8::gemm_phase<pg8::EpiGateUp, pg8::StaticOrder, true>(lds, g, S, E);
#ifdef PROBE_DUP_GU
            if (pass == 0) pg8::gemm_phase<pg8::EpiGateUp, pg8::StaticOrder>(lds, g, S, E);
#endif
        }
        SEAM(pu);
        if (IN(pd)) {
            if (pass == 0 && wave == 0) meta_down(HFFM, (const bf16_t*)(ws + WS_WD1), H, SSQ1, (int)blockIdx.x, G, lane);
            pg8::Gemm g{(const bf16_t*)HFF, (const bf16_t*)(ws + (pass ? WS_WD2_8 : WS_WD1_8)), NREAL, D, FF / 2}; pg8::StaticOrder S; S.init(NREAL, D, G, (int)blockIdx.x);
            pg8::EpiResid E{H, pass ? SSQ3 : SSQ1, pass ? nullptr : ws + WS_H8, 1.0f / (HFF8_SCALE * WD8_SCALE)};
            pg8::gemm_phase<pg8::EpiResid, pg8::StaticOrder, true>(lds, g, S, E);
        }
        SEAM(pd);
        if (pass == 0) {
            if (IN(3)) {
                if (wave == 0) meta_win(H, (const bf16_t*)(ws + WS_WIN), U3, VT, SSQ1, (int)blockIdx.x, G, lane);
                { pg8::Gemm g{H, (const bf16_t*)(ws + WS_WIN), NREAL, 1536, D}; pg8::StaticOrder S; S.init(NREAL, 1536, G, (int)blockIdx.x);
                  pg8::EpiRowScale E{U3, 1536, SSQ1};
                  pg8::gemm_phase<pg8::EpiRowScale, pg8::StaticOrder>(lds, g, S, E); }
                { pg8::Gemm g{(const bf16_t*)(ws + WS_WV8), (const bf16_t*)(ws + WS_H8), 512, NREAL, D / 2}; pg8::StaticOrder S; S.init(512, NREAL, G, (int)blockIdx.x);
                  pg8::EpiColScale E{VT, MPAD, SSQ1, 1.0f / W8_SCALE};
                  pg8::gemm_phase<pg8::EpiColScale, pg8::StaticOrder, true>(lds, g, S, E); }
            }
            SEAM(3);
            if (IN(4)) {
                int ll = lane; asm volatile("" : "+v"(ll));
                const float s1 = wave_sum(a.in[10][ll] * a.in[11][ll]), s2 = wave_sum(a.in[12][ll] * a.in[13][ll]);
                const float lam = __expf(s1) - __expf(s2) + 0.2f;
                att::attn_phase(lds, U3, VT, MIX, a.in[3], a.in[14], lam, (unsigned*)(ws + WS_CTL));
                pool_phase(U3, MIX, (unsigned*)(ws + WS_CTL) + 15 * 64, ll);
#ifdef PROBE_DUP_ATT
                att::attn_phase(lds, U3, VT, MIX, a.in[3], a.in[14], lam, (unsigned*)(ws + WS_CTL) + 8 * 64);
#endif
            }
            SEAM(4);
            if (IN(5)) {
                pg8::Gemm g{MIX, (const bf16_t*)(ws + WS_WOUT), NREAL, D, D}; pg8::StaticOrder S; S.init(NREAL, D, G, (int)blockIdx.x);
                pg8::EpiResid E{H, SSQ2, ws + WS_H8, 1.0f};
                pg8::gemm_phase<pg8::EpiResid, pg8::StaticOrder>(lds, g, S, E);
            }
            SEAM(5);
        }
    }
    if (IN(8)) {
        const float* gf = a.in[22];
        for (int orow0 = gw * 4; orow0 < NOUT_ROWS; orow0 += NGW * 4) {
            u32x4 hv[4][2]; float rs[4];
#pragma unroll
            for (int i = 0; i < 4; ++i) { const int row = orow0 + i;
                rs[i] = rstd_of(SSQ3, row);
#pragma unroll
                for (int j = 0; j < 2; ++j) hv[i][j] = *(const u32x4*)(H + (size_t)row * D + (j * 64 + lane) * 8); }
#pragma unroll
            for (int j = 0; j < 2; ++j) { const int col = (j * 64 + lane) * 8; const f32x4 g0 = *(const f32x4*)(gf + col), g1 = *(const f32x4*)(gf + col + 4);
#pragma unroll
                for (int i = 0; i < 4; ++i) { const u32x4 h4 = hv[i][j]; const float r = rs[i];
                    f32x4 o0, o1; o0.x = bf_lo(h4.x) * r * g0.x; o0.y = bf_hi(h4.x) * r * g0.y; o0.z = bf_lo(h4.y) * r * g0.z; o0.w = bf_hi(h4.y) * r * g0.w;
                    o1.x = bf_lo(h4.z) * r * g1.x; o1.y = bf_hi(h4.z) * r * g1.y; o1.z = bf_lo(h4.w) * r * g1.z; o1.w = bf_hi(h4.w) * r * g1.w;
                    float* op = a.out + (size_t)(orow0 + i) * D + col; *(f32x4*)op = o0; *(f32x4*)(op + 4) = o1; } }
        }
    }
#undef IN
#undef SEAM
}

constexpr int LDS_BYTES = 147456;
extern "C" void kernel_launch(void* const* d_in, const int* in_sizes, int n_in, void* d_out, int out_size, void* d_ws, size_t ws_size, hipStream_t stream) {
    static int grid = 0;
    if (grid == 0) {
        if (n_in != 23 || out_size != NOUT_ROWS * D || ws_size < WS_END) { fprintf(stderr, "kernel_launch: unexpected shapes (n_in %d, out %d, ws %zu < %zu)\n", n_in, out_size, ws_size, (size_t)WS_END); grid = -1; return; }
        int dev = 0, cus = 0, per_cu = 0;
        (void)hipGetDevice(&dev); (void)hipDeviceGetAttribute(&cus, hipDeviceAttributeMultiprocessorCount, dev);
        (void)hipFuncSetAttribute((const void*)mk_fwd, hipFuncAttributeMaxDynamicSharedMemorySize, LDS_BYTES);
        if (hipOccupancyMaxActiveBlocksPerMultiprocessor(&per_cu, (const void*)mk_fwd, 512, LDS_BYTES) != hipSuccess || per_cu < 1) per_cu = 1;
        (void)hipGetLastError();
        grid = cus * 1;
        if (grid <= 0) grid = 256;
    }
    if (grid < 0) return;
    Args a{};
    for (int i = 0; i < 23; ++i) a.in[i] = (const float*)d_in[i];
    a.out = (float*)d_out; a.ws = (unsigned char*)d_ws;
#if MK_MULTI
    for (int p = 0; p < 9; ++p) { a.ph_lo = p; a.ph_hi = p + 1; hipLaunchKernelGGL(mk_fwd, dim3(grid), dim3(512), LDS_BYTES, stream, a); }
#else
    a.ph_lo = 0; a.ph_hi = 9;
    void* args[] = {&a};
    hipError_t e = hipLaunchCooperativeKernel((const void*)mk_fwd, dim3(grid), dim3(512), args, LDS_BYTES, stream);
    if (e != hipSuccess) fprintf(stderr, "cooperative launch failed: %s (grid %d)\n", hipGetErrorString(e), grid);
#endif
}
```
